# Optimizing an MI355X kernel written in HIP

```python
import math
import jax, jax.numpy as jnp
from jax import lax
import numpy as np

D_MODEL = 1024
BATCH = 16
SEQ = 256
DEPTH = 2
DEC_BATCH = 2
DEC_SEQ = 4096
PAST_LEN = 256

GRID_W = 64
N_MIXERS = 2
N_HEADS = 16
N_KV_HEADS = 4
HEAD_DIM = 64
GROUP = N_HEADS // N_KV_HEADS
QKV_DIM = (N_HEADS + 2 * N_KV_HEADS) * HEAD_DIM
WINDOW = 128
BLOCK = 128
ROPE_BASE = 10000.0
N_FREQ = HEAD_DIM // 4
POOL_WINDOWS = (2, 4, 8, 16)
N_POOL_GROUPS = 4
POOL_GROUP_DIM = D_MODEL // N_POOL_GROUPS
D_FF = 2816
N_ATTN_LAYERS = (DEPTH + 1) // 2
N_POOL_LAYERS = DEPTH // 2
N_MOD = 9
LN_EPS = 1e-5
DEEPNORM_ALPHA = (2.0 * DEPTH) ** 0.25
DEEPNORM_BETA = (8.0 * DEPTH) ** -0.25
ATTN_SCALE = HEAD_DIM ** -0.5
NEG_INF = -1e30

kernel_name = "hybrid_diffusion_window_gqa_pool_macaron_step"


def layer_norm(x, g, b):
    xf = x.astype(jnp.float32)
    mu = xf.mean(-1, keepdims=True)
    var = jnp.square(xf - mu).mean(-1, keepdims=True)
    y = (xf - mu) * lax.rsqrt(var + LN_EPS)
    return (y * g.astype(jnp.float32) + b.astype(jnp.float32)).astype(x.dtype)


def residual_post_norm(x, out, gate, g, b):
    return layer_norm(DEEPNORM_ALPHA * x + gate * out, g, b)


def adaln_params(cond, w_mod, b_mod):
    m = (jax.nn.silu(cond) @ w_mod + b_mod)[..., None, :]
    return jnp.split(m, N_MOD, axis=-1)


def modulate(x, shift, scale):
    return x * (1.0 + scale) + shift


def swiglu(x, w_gate, w_up, w_down):
    return (jax.nn.silu(x @ w_gate) * (x @ w_up)) @ w_down


def axial_rope_tables(n_rows, dtype):
    rows = jnp.repeat(jnp.arange(n_rows, dtype=jnp.float32), GRID_W)
    cols = jnp.tile(jnp.arange(GRID_W, dtype=jnp.float32), n_rows)
    inv = jnp.power(ROPE_BASE, -jnp.arange(N_FREQ, dtype=jnp.float32) / N_FREQ)
    ang_r = rows[:, None] * inv
    ang_c = cols[:, None] * inv
    ang = jnp.concatenate([ang_r, ang_r, ang_c, ang_c], axis=-1)
    return jnp.cos(ang).astype(dtype), jnp.sin(ang).astype(dtype)


def apply_axial_rope(x, cos, sin):
    r1, r2, c1, c2 = jnp.split(x, 4, axis=-1)
    rot = jnp.concatenate([-r2, r1, -c2, c1], axis=-1)
    return x * cos[None, :, None, :] + rot * sin[None, :, None, :]


def split_qkv(h, w_qkv):
    B, S, _ = h.shape
    qkv = h @ w_qkv
    q, k, v = jnp.split(qkv, [N_HEADS * HEAD_DIM, (N_HEADS + N_KV_HEADS) * HEAD_DIM], axis=-1)
    q = q.reshape(B, S, N_HEADS, HEAD_DIM)
    k = k.reshape(B, S, N_KV_HEADS, HEAD_DIM)
    v = v.reshape(B, S, N_KV_HEADS, HEAD_DIM)
    return q, k, v


def to_query_blocks(q):
    B, S = q.shape[:2]
    qb = q.reshape(B, S // BLOCK, BLOCK, N_KV_HEADS, GROUP, HEAD_DIM)
    return qb.transpose(1, 0, 2, 3, 4, 5)


def from_query_blocks(o):
    nb, B = o.shape[:2]
    return o.transpose(1, 0, 2, 3, 4, 5).reshape(B, nb * BLOCK, N_HEADS * HEAD_DIM)


def sink_column(sink, score_shape):
    s = sink.astype(jnp.float32).reshape(N_KV_HEADS, GROUP)[None, :, :, None, None]
    return jnp.broadcast_to(s, score_shape[:-1] + (1,))


def context_attention(q, k, v, sink):
    L = k.shape[1]

    def one_block(q_blk):
        s = jnp.einsum('bqkgd,bjkd->bkgqj', q_blk, k).astype(jnp.float32) * ATTN_SCALE
        logits = jnp.concatenate([s, sink_column(sink, s.shape)], axis=-1)
        p = jax.nn.softmax(logits, axis=-1)[..., :L].astype(v.dtype)
        return jnp.einsum('bkgqj,bjkd->bqkgd', p, v)

    return from_query_blocks(lax.map(one_block, to_query_blocks(q)))


def latent_attention(q, k, v, k_ctx, v_ctx, sink):
    S = q.shape[1]
    L = k_ctx.shape[1]
    nb = S // BLOCK
    pad = ((0, 0), (BLOCK, BLOCK), (0, 0), (0, 0))
    k_pad = jnp.pad(k, pad)
    v_pad = jnp.pad(v, pad)
    offs_q = jnp.arange(BLOCK)
    offs_k = jnp.arange(3 * BLOCK) - BLOCK

    def one_block(args):
        q_blk, b = args
        start = b * BLOCK
        kb = lax.dynamic_slice_in_dim(k_pad, start, 3 * BLOCK, axis=1)
        vb = lax.dynamic_slice_in_dim(v_pad, start, 3 * BLOCK, axis=1)
        qpos = start + offs_q
        kpos = start + offs_k
        valid = ((jnp.abs(qpos[:, None] - kpos[None, :]) <= WINDOW)
                 & (kpos >= 0)[None, :] & (kpos < S)[None, :])
        s_loc = jnp.einsum('bqkgd,bjkd->bkgqj', q_blk, kb).astype(jnp.float32) * ATTN_SCALE
        s_loc = jnp.where(valid, s_loc, NEG_INF)
        s_ctx = jnp.einsum('bqkgd,bjkd->bkgqj', q_blk, k_ctx).astype(jnp.float32) * ATTN_SCALE
        logits = jnp.concatenate([s_loc, s_ctx, sink_column(sink, s_loc.shape)], axis=-1)
        p = jax.nn.softmax(logits, axis=-1).astype(v.dtype)
        p_loc = p[..., :3 * BLOCK]
        p_ctx = p[..., 3 * BLOCK:3 * BLOCK + L]
        return (jnp.einsum('bkgqj,bjkd->bqkgd', p_loc, vb)
                + jnp.einsum('bkgqj,bjkd->bqkgd', p_ctx, v_ctx))

    return from_query_blocks(lax.map(one_block, (to_query_blocks(q), jnp.arange(nb))))


def attn_context(h, w_qkv, w_o, sink):
    q, k, v = split_qkv(h, w_qkv)
    o = context_attention(q, k, v, sink)
    return o @ w_o, k, v


def attn_latent(h, k_ctx, v_ctx, cos, sin, w_qkv, w_o, sink):
    q, k, v = split_qkv(h, w_qkv)
    q = apply_axial_rope(q, cos, sin)
    k = apply_axial_rope(k, cos, sin)
    o = latent_attention(q, k, v, k_ctx, v_ctx, sink)
    return o @ w_o


def multiscale_pool(h, w_pool, scale):
    B, S, D = h.shape
    hf = h.astype(jnp.float32)
    cs = jnp.concatenate([jnp.zeros((B, 1, D), jnp.float32), jnp.cumsum(hf, axis=1)], axis=1)
    t = jnp.arange(S)
    outs = []
    for gi, w in enumerate(POOL_WINDOWS):
        lo = jnp.clip(t - w // 2, 0, S)
        hi = jnp.clip(t + w // 2, 0, S)
        sl = slice(gi * POOL_GROUP_DIM, (gi + 1) * POOL_GROUP_DIM)
        cg = cs[..., sl]
        total = jnp.take(cg, hi, axis=1) - jnp.take(cg, lo, axis=1)
        cnt = (hi - lo).astype(jnp.float32)[None, :, None]
        pooled = (total / cnt - hf[..., sl]).astype(h.dtype)
        outs.append(pooled @ w_pool[gi])
    return jnp.concatenate(outs, axis=-1) * scale


def setup_inputs(seed: int = 0) -> dict:
    key = jax.random.key(seed)
    ks = jax.random.split(key, 20)
    f32 = jnp.float32
    nrm = lambda k, shape: jax.random.normal(k, shape, f32)
    d_inner = N_HEADS * HEAD_DIM
    return {
        'x_prompt': nrm(ks[0], (BATCH, SEQ, D_MODEL)),
        'x_sample': nrm(ks[1], (DEC_BATCH, DEC_SEQ, D_MODEL)),
        'cache_k': nrm(ks[2], (DEC_BATCH, N_ATTN_LAYERS, PAST_LEN, N_KV_HEADS, HEAD_DIM)),
        'cache_v': nrm(ks[3], (DEC_BATCH, N_ATTN_LAYERS, PAST_LEN, N_KV_HEADS, HEAD_DIM)),
        'c': nrm(ks[4], (DEC_BATCH, D_MODEL)),
        'c_ctx': nrm(ks[5], (D_MODEL,)),
        'w_mod': nrm(ks[6], (DEPTH, D_MODEL, N_MOD * D_MODEL)) * (0.5 * D_MODEL ** -0.5),
        'b_mod': nrm(ks[7], (DEPTH, N_MOD * D_MODEL)) * 0.01,
        'ln_g': 1.0 + 0.05 * nrm(ks[8], (DEPTH, 3, D_MODEL)),
        'ln_b': 0.02 * nrm(ks[9], (DEPTH, 3, D_MODEL)),
        'ffn_w_gate': nrm(ks[10], (DEPTH, 2, D_MODEL, D_FF)) * D_MODEL ** -0.5,
        'ffn_w_up': nrm(ks[11], (DEPTH, 2, D_MODEL, D_FF)) * D_MODEL ** -0.5,
        'ffn_w_down': nrm(ks[12], (DEPTH, 2, D_FF, D_MODEL)) * (DEEPNORM_BETA * D_FF ** -0.5),
        'attn_w_qkv': nrm(ks[13], (N_ATTN_LAYERS, D_MODEL, QKV_DIM)) * D_MODEL ** -0.5,
        'attn_w_o': nrm(ks[14], (N_ATTN_LAYERS, d_inner, D_MODEL)) * (DEEPNORM_BETA * d_inner ** -0.5),
        'attn_sink': 0.5 * nrm(ks[15], (N_ATTN_LAYERS, N_HEADS)),
        'pool_w': nrm(ks[16], (N_POOL_LAYERS, N_POOL_GROUPS, POOL_GROUP_DIM, POOL_GROUP_DIM)) * (DEEPNORM_BETA * POOL_GROUP_DIM ** -0.5),
        'pool_scale': 1.0 + 0.1 * nrm(ks[17], (N_POOL_LAYERS, D_MODEL)),
    }


def reference(x_prompt, x_sample, cache_k, cache_v, c, c_ctx, w_mod, b_mod, ln_g, ln_b,
              ffn_w_gate, ffn_w_up, ffn_w_down, attn_w_qkv, attn_w_o, attn_sink,
              pool_w, pool_scale):
    n_rows = x_sample.shape[1] // GRID_W
    cos, sin = axial_rope_tables(n_rows, x_sample.dtype)
    xp, xs = x_prompt, x_sample
    new_k, new_v = [], []
    for i in range(DEPTH):
        mix = i % N_MIXERS
        j = i // N_MIXERS
        mp = adaln_params(c_ctx, w_mod[i], b_mod[i])
        ms = adaln_params(c, w_mod[i], b_mod[i])

        fp = swiglu(modulate(xp, mp[0], mp[1]), ffn_w_gate[i, 0], ffn_w_up[i, 0], ffn_w_down[i, 0])
        fs = swiglu(modulate(xs, ms[0], ms[1]), ffn_w_gate[i, 0], ffn_w_up[i, 0], ffn_w_down[i, 0])
        xp = residual_post_norm(xp, 0.5 * fp, mp[2], ln_g[i, 0], ln_b[i, 0])
        xs = residual_post_norm(xs, 0.5 * fs, ms[2], ln_g[i, 0], ln_b[i, 0])

        hp = modulate(xp, mp[3], mp[4])
        hs = modulate(xs, ms[3], ms[4])
        if mix == 0:
            op, k_p, v_p = attn_context(hp, attn_w_qkv[j], attn_w_o[j], attn_sink[j])
            new_k.append(k_p)
            new_v.append(v_p)
            os_ = attn_latent(hs, cache_k[:, j], cache_v[:, j], cos, sin,
                              attn_w_qkv[j], attn_w_o[j], attn_sink[j])
        else:
            op = multiscale_pool(hp, pool_w[j], pool_scale[j])
            os_ = multiscale_pool(hs, pool_w[j], pool_scale[j])
        xp = residual_post_norm(xp, op, mp[5], ln_g[i, 1], ln_b[i, 1])
        xs = residual_post_norm(xs, os_, ms[5], ln_g[i, 1], ln_b[i, 1])

        fp = swiglu(modulate(xp, mp[6], mp[7]), ffn_w_gate[i, 1], ffn_w_up[i, 1], ffn_w_down[i, 1])
        fs = swiglu(modulate(xs, ms[6], ms[7]), ffn_w_gate[i, 1], ffn_w_up[i, 1], ffn_w_down[i, 1])
        xp = residual_post_norm(xp, 0.5 * fp, mp[8], ln_g[i, 2], ln_b[i, 2])
        xs = residual_post_norm(xs, 0.5 * fs, ms[8], ln_g[i, 2], ln_b[i, 2])

    state_k = jnp.stack(new_k, axis=1)
    state_v = jnp.stack(new_v, axis=1)
    return (xp, xs, state_k, state_v)
```

```cpp
#include <hip/hip_runtime.h>
#include <hip/hip_cooperative_groups.h>
#include <cstdio>
#include <cstdint>
#ifndef MK_PER_PHASE
#define MK_PER_PHASE 0
#endif
namespace pg8 {
#define PG8_LAS __attribute__((address_space(3)))
typedef unsigned short bf16_t;
typedef short bf16x8 __attribute__((ext_vector_type(8)));
typedef float f32x4 __attribute__((ext_vector_type(4)));
typedef unsigned u32x4 __attribute__((ext_vector_type(4)));
constexpr int BM = 256, BK = 64, HALF = 128, HTB = HALF * BK * 2  , STAGE_BYTES = 8 * HTB, NXCD = 8, WGM = 8;

__host__ __device__ __forceinline__ int lds_byte(int r, int c) { const int st = (r >> 4) * 2 + (c >> 5), rr = r & 15, cc = c & 31, ob = rr * 64 + cc * 2; return st * 1024 + (ob ^ (((ob >> 9) & 1) << 5)); }
__host__ __device__ __forceinline__ void stage_rc(int b, int& R, int& C) { const int st = b / 1024, sb = b % 1024, swz = sb ^ (((sb >> 9) & 1) << 5); R = (st >> 1) * 16 + swz / 64; C = (st & 1) * 32 + (swz % 64) / 2; }
__host__ __device__ __forceinline__ int perm32(int rho) { const int n = rho >> 4, i = rho & 15; return 8 * (i >> 2) + 4 * n + (i & 3); }

struct Unit { int pm, pn; };
struct Gemm { const bf16_t* A; const bf16_t* Bt; int M, N, K; };

struct StaticOrder {
    int nM, nN, nwg, G, c;
    __host__ __device__ void init(int M, int N, int G_, int c_) { nM = M / BM; nN = N / BM; nwg = nM * nN; G = G_; c = c_; }
    __host__ __device__ bool next(int i, Unit& u) const {
        const long L = (long)i * G + c; if (L >= nwg) return false;
        int wgid = (int)L; { const int q = nwg / NXCD, r = nwg % NXCD, xcd = wgid % NXCD, off = wgid / NXCD; wgid = (xcd < r ? xcd * (q + 1) : r * (q + 1) + (xcd - r) * q) + off; }
        const int nig = WGM * nN, gid = wgid / nig, fm = gid * WGM, gsz = (nM - fm) < WGM ? (nM - fm) : WGM;
        u.pm = fm + ((wgid % nig) % gsz); u.pn = (wgid % nig) / gsz; return true;
    }
    __device__ __forceinline__ void a_ready(const Unit&) const {}
    __device__ __forceinline__ void done(const Unit&) const {}
};

__device__ __forceinline__ unsigned cvt_pk_bf16(float lo, float hi) { unsigned r; asm volatile("v_cvt_pk_bf16_f32 %0, %1, %2" : "=v"(r) : "v"(lo), "v"(hi)); return r; }
template <class Epi, class Sched, bool ALIGN_EPI = false, bool SP2 = false>
__device__ __forceinline__ void gemm_phase(PG8_LAS unsigned char* lds, const Gemm g, const Sched& S, const Epi& E) {
    const int tid = threadIdx.x, wid = __builtin_amdgcn_readfirstlane(tid >> 6), lane = tid & 63, wr = wid >> 2, wc = wid & 3, fr = lane & 15, fq = lane >> 4;
    const int K = g.K, nt = K / BK;
    unsigned voffA[2], voffB[2];
#pragma unroll
    for (int i = 0; i < 2; ++i) { int R, C; stage_rc(tid * 16 + i * 8192, R, C); const int Rb = Epi::PERM ? ((R & ~31) + perm32(R & 31)) : R;
        voffA[i] = (unsigned)(R * K + C) * 2u; voffB[i] = (unsigned)(Rb * K + C) * 2u; }
    const size_t kstep = (size_t)(BK * 2);
    const size_t hstep = (size_t)HALF * K * 2;
    const size_t tstep = 2 * hstep;
    const unsigned ldsw = (unsigned)wid * 1024u;
    const int aoff = lds_byte(wr * 64 + fr, fq * 8), boff = lds_byte(wc * 32 + fr, fq * 8);
#define PG8_SA(b, h) (((b) * 2 + (h)) * HTB)
#define PG8_SB(b, h) ((4 + (b) * 2 + (h)) * HTB)
#define PG8_STAGE(bufoff, gbase, voff) do { _Pragma("unroll") for (int _i = 0; _i < 2; ++_i) \
        __builtin_amdgcn_global_load_lds((const unsigned*)((const char*)(gbase) + (voff)[_i]), (PG8_LAS unsigned*)(lds + (bufoff) + ldsw + _i * 8192), 16, 0, 0); } while (0)
#define PG8_LDA(dst, b, h) do { _Pragma("unroll") for (int m = 0; m < 4; ++m) _Pragma("unroll") for (int k = 0; k < 2; ++k) dst[m][k] = *(const PG8_LAS bf16x8*)(lds + PG8_SA(b, h) + aoff + m * 2048 + k * 1024); } while (0)
#define PG8_LDB(dst, b, h) do { _Pragma("unroll") for (int n = 0; n < 2; ++n) _Pragma("unroll") for (int k = 0; k < 2; ++k) dst[n][k] = *(const PG8_LAS bf16x8*)(lds + PG8_SB(b, h) + boff + n * 2048 + k * 1024); } while (0)
#define PG8_MMA(ai, bj, At, Bt) do { __builtin_amdgcn_s_setprio(1); _Pragma("unroll") for (int m = 0; m < 4; ++m) _Pragma("unroll") for (int n = 0; n < 2; ++n) _Pragma("unroll") for (int k = 0; k < 2; ++k) \
        acc[ai][bj][m][n] = __builtin_amdgcn_mfma_f32_16x16x32_bf16(Bt[n][k], At[m][k], acc[ai][bj][m][n], 0, 0, 0); __builtin_amdgcn_s_setprio(0); } while (0)
#define PG8_WAIT_V(n) asm volatile("s_waitcnt vmcnt(" #n ")" ::: "memory")
#define PG8_WAIT_L(n) asm volatile("s_waitcnt lgkmcnt(" #n ")" ::: "memory")
#define PG8_BAR __builtin_amdgcn_s_barrier()
#define PG8_SCHED __builtin_amdgcn_sched_barrier(0)
    Unit cur, nxt; int ui = 0;
    if (!S.next(0, cur)) return;
    f32x4 acc[2][2][4][2];
#pragma unroll
    for (int a = 0; a < 2; ++a)
#pragma unroll
        for (int b = 0; b < 2; ++b)
#pragma unroll
            for (int m = 0; m < 4; ++m)
#pragma unroll
                for (int n = 0; n < 2; ++n) acc[a][b][m][n] = (f32x4){0.f, 0.f, 0.f, 0.f};
    bf16x8 At[4][2], B0[2][2], B1[2][2];
    const char* cA = (const char*)g.A + (size_t)cur.pm * tstep; const char* cB = (const char*)g.Bt + (size_t)cur.pn * tstep;
    S.a_ready(cur);
    if constexpr (SP2) {
        PG8_STAGE(PG8_SB(0, 0), cB, voffB); PG8_STAGE(PG8_SB(0, 1), cB + hstep, voffB); PG8_STAGE(PG8_SA(0, 0), cA, voffA); PG8_STAGE(PG8_SA(0, 1), cA + hstep, voffA);
        if (wr == 1) PG8_BAR;
        PG8_WAIT_V(2); PG8_BAR;
        PG8_STAGE(PG8_SB(1, 0), cB + kstep, voffB); PG8_STAGE(PG8_SA(1, 0), cA + kstep, voffA); PG8_STAGE(PG8_SB(1, 1), cB + hstep + kstep, voffB);
        PG8_WAIT_V(6); PG8_BAR;
    } else {
        PG8_STAGE(PG8_SB(0, 0), cB, voffB); PG8_STAGE(PG8_SA(0, 0), cA, voffA); PG8_STAGE(PG8_SB(0, 1), cB + hstep, voffB); PG8_STAGE(PG8_SA(0, 1), cA + hstep, voffA);
        if (wr == 1) PG8_BAR;
        PG8_WAIT_V(4); PG8_BAR;
        PG8_STAGE(PG8_SB(1, 0), cB + kstep, voffB); PG8_STAGE(PG8_SA(1, 0), cA + kstep, voffA); PG8_STAGE(PG8_SB(1, 1), cB + hstep + kstep, voffB);
        PG8_WAIT_V(6); PG8_BAR;
    }
    for (;;) {
        const bool has_next = S.next(ui + 1, nxt);
        const char* nA = has_next ? (const char*)g.A + (size_t)nxt.pm * tstep : cA; const char* nB = has_next ? (const char*)g.Bt + (size_t)nxt.pn * tstep : cB;
        for (int t = 0; t < nt; t += 2) {
            const bool last = (t == nt - 2);
            const char* a1 = cA + (size_t)(t + 1) * kstep;
            const char* a2 = last ? nA : cA + (size_t)(t + 2) * kstep; const char* b2 = last ? nB : cB + (size_t)(t + 2) * kstep;
            const char* a3 = a2 + kstep; const char* b3 = b2 + kstep;
            if (last && has_next) S.a_ready(nxt);
            if constexpr (SP2) {
            PG8_LDB(B0, 0, 0); PG8_LDB(B1, 0, 1); PG8_SCHED; PG8_LDA(At, 0, 0); PG8_STAGE(PG8_SA(1, 1), a1 + hstep, voffA);
            PG8_WAIT_V(8); PG8_WAIT_L(0); PG8_BAR; PG8_MMA(0, 0, At, B0); PG8_MMA(0, 1, At, B1); PG8_BAR; PG8_SCHED;
            PG8_LDA(At, 0, 1); PG8_STAGE(PG8_SB(0, 0), b2, voffB); PG8_STAGE(PG8_SB(0, 1), b2 + hstep, voffB); PG8_STAGE(PG8_SA(0, 0), a2, voffA);
            PG8_WAIT_V(8); PG8_WAIT_L(0); PG8_BAR; PG8_MMA(1, 0, At, B0); PG8_MMA(1, 1, At, B1); PG8_BAR; PG8_SCHED;
            PG8_LDB(B0, 1, 0); PG8_LDB(B1, 1, 1); PG8_SCHED; PG8_LDA(At, 1, 0); PG8_STAGE(PG8_SA(0, 1), a2 + hstep, voffA);
            PG8_WAIT_V(8); PG8_WAIT_L(0); PG8_BAR; PG8_MMA(0, 0, At, B0); PG8_MMA(0, 1, At, B1); PG8_BAR; PG8_SCHED;
            PG8_LDA(At, 1, 1); PG8_STAGE(PG8_SB(1, 0), b3, voffB); PG8_STAGE(PG8_SB(1, 1), b3 + hstep, voffB); PG8_STAGE(PG8_SA(1, 0), a3, voffA);
            PG8_WAIT_V(8); PG8_WAIT_L(0); PG8_BAR; PG8_MMA(1, 0, At, B0); PG8_MMA(1, 1, At, B1); PG8_BAR; PG8_SCHED;
            } else {
            PG8_LDB(B0, 0, 0); PG8_SCHED; PG8_LDA(At, 0, 0); PG8_STAGE(PG8_SA(1, 1), a1 + hstep, voffA);
            PG8_WAIT_L(8); PG8_BAR; PG8_WAIT_L(0); PG8_MMA(0, 0, At, B0); PG8_BAR; PG8_SCHED;
            PG8_LDB(B1, 0, 1); PG8_STAGE(PG8_SB(0, 0), b2, voffB);
            PG8_BAR; PG8_WAIT_L(0); PG8_MMA(0, 1, At, B1); PG8_BAR;
            PG8_LDA(At, 0, 1); PG8_STAGE(PG8_SA(0, 0), a2, voffA);
            PG8_BAR; PG8_WAIT_L(0); PG8_MMA(1, 0, At, B0); PG8_BAR; PG8_SCHED;
            PG8_STAGE(PG8_SB(0, 1), b2 + hstep, voffB);
            PG8_WAIT_V(6); PG8_BAR; PG8_MMA(1, 1, At, B1); PG8_BAR;
            PG8_LDB(B0, 1, 0); PG8_SCHED; PG8_LDA(At, 1, 0); PG8_STAGE(PG8_SA(0, 1), a2 + hstep, voffA);
            PG8_WAIT_L(8); PG8_BAR; PG8_WAIT_L(0); PG8_MMA(0, 0, At, B0); PG8_BAR; PG8_SCHED;
            PG8_LDB(B1, 1, 1); PG8_STAGE(PG8_SB(1, 0), b3, voffB);
            PG8_BAR; PG8_WAIT_L(0); PG8_MMA(0, 1, At, B1); PG8_BAR;
            PG8_LDA(At, 1, 1); PG8_STAGE(PG8_SA(1, 0), a3, voffA);
            PG8_BAR; PG8_WAIT_L(0); PG8_MMA(1, 0, At, B0); PG8_BAR; PG8_SCHED;
            PG8_STAGE(PG8_SB(1, 1), b3 + hstep, voffB);
            PG8_WAIT_V(6); PG8_BAR; PG8_MMA(1, 1, At, B1); PG8_BAR;
            }
        }
        if constexpr (ALIGN_EPI) { if (wr == 0) PG8_BAR; }
        if constexpr (!Epi::AFTER_DRAIN) { E(acc, cur, wr, wc, fr, fq); S.done(cur); }
        if (!has_next) break;
#pragma unroll
        for (int a = 0; a < 2; ++a)
#pragma unroll
            for (int b = 0; b < 2; ++b)
#pragma unroll
                for (int m = 0; m < 4; ++m)
#pragma unroll
                    for (int n = 0; n < 2; ++n) acc[a][b][m][n] = (f32x4){0.f, 0.f, 0.f, 0.f};
        cur = nxt; cA = nA; cB = nB; ++ui;
        if constexpr (ALIGN_EPI) { if (wr == 1) PG8_BAR; }
    }
    PG8_WAIT_V(0);
    if constexpr (!ALIGN_EPI) { if (wr == 0) PG8_BAR; }
    PG8_BAR;
    if constexpr (Epi::AFTER_DRAIN) { E.fused(acc, cur, wr, wc, fr, fq, lds, wid, lane); S.done(cur); }
#undef PG8_SA
#undef PG8_SB
#undef PG8_STAGE
#undef PG8_LDA
#undef PG8_LDB
#undef PG8_MMA
#undef PG8_WAIT_V
#undef PG8_WAIT_L
#undef PG8_BAR
#undef PG8_SCHED
}
}

namespace cg = cooperative_groups;
#define LAS __attribute__((address_space(3)))
typedef unsigned short bf16;
typedef unsigned v4u __attribute__((ext_vector_type(4)));
typedef unsigned v2u __attribute__((ext_vector_type(2)));
typedef float f32x4 __attribute__((ext_vector_type(4)));
typedef short bf16x8 __attribute__((ext_vector_type(8)));
typedef short s16x4 __attribute__((ext_vector_type(4)));

constexpr int NWAVES = 8;
constexpr int T = 12288, TP = 4096, D = 1024, FF = 2816, NGU = 5632, NQKV = 1536, NMOD = 9216;
constexpr float ALPHA = 1.4142135623730951f;
constexpr float LN_EPS = 1e-5f;
constexpr float LOG2E = 1.4426950408889634f;
constexpr int LDS_BYTES = 147456;
constexpr int N_PHASES = 22;

constexpr size_t MiB = 1u << 20;
constexpr size_t WS_MODV = 1 * MiB;
constexpr size_t WS_ROPE = 1 * MiB + 512 * 1024;
constexpr size_t WS_KC = 2 * MiB;
constexpr size_t WS_VCT = 2 * MiB + 512 * 1024;
constexpr size_t WS_PART = 4 * MiB;
constexpr size_t WS_WQKV = 8 * MiB, WS_WO = 11 * MiB, WS_WP = 13 * MiB;
constexpr size_t WS_WGU = 16 * MiB;
constexpr size_t WS_WD = 60 * MiB;
constexpr size_t WS_H = 82 * MiB;
constexpr size_t WS_A = 106 * MiB;
constexpr size_t WS_Q = 106 * MiB, WS_O = 130 * MiB;
constexpr size_t WS_KB = 172 * MiB;
constexpr size_t WS_VT = 178 * MiB;
constexpr size_t WS_END = 184 * MiB;

struct Args {
    const float* in[18];
    float* out;
    unsigned char* ws;
    int ph_lo, ph_hi;
};

#define LDS_WAIT() asm volatile("s_waitcnt lgkmcnt(0)" ::: "memory")
__device__ __forceinline__ unsigned pkbf(float lo, float hi) { return pg8::cvt_pk_bf16(lo, hi); }
__device__ __forceinline__ float wave_sum(float v) {
#pragma unroll
    for (int o = 1; o < 64; o <<= 1) v += __shfl_xor(v, o);
    return v;
}
__device__ __forceinline__ float silu_f(float x) { return x / (1.f + __expf(-x)); }

struct EpiSwiglu {
    static constexpr bool PERM = true, AFTER_DRAIN = false;
    bf16* A;
    __device__ __forceinline__ void operator()(const f32x4 (&acc)[2][2][4][2], const pg8::Unit& u, int wr, int wc, int fr, int fq) const {
        const int col = u.pn * 128 + wc * 32 + 8 * fq;
#pragma unroll
        for (int ai = 0; ai < 2; ++ai)
#pragma unroll
            for (int m = 0; m < 4; ++m) {
                const int row = u.pm * 256 + ai * 128 + wr * 64 + m * 16 + fr;
                float v[8];
#pragma unroll
                for (int n = 0; n < 2; ++n)
#pragma unroll
                    for (int e = 0; e < 4; ++e) { const float g = acc[ai][0][m][n][e], up = acc[ai][1][m][n][e]; v[n * 4 + e] = g * __builtin_amdgcn_rcpf(1.f + __expf(-g)) * up; }
                v4u w; w.x = pkbf(v[0], v[1]); w.y = pkbf(v[2], v[3]); w.z = pkbf(v[4], v[5]); w.w = pkbf(v[6], v[7]);
                *(v4u*)(A + (size_t)row * FF + col) = w;
            }
    }
};
struct EpiResid {
    static constexpr bool PERM = false, AFTER_DRAIN = false;
    float* xy; const float* gate; const float* cscale; float mult;
    __device__ __forceinline__ void operator()(const f32x4 (&acc)[2][2][4][2], const pg8::Unit& u, int wr, int wc, int fr, int fq) const {
        const int cond = u.pm < 16 ? 0 : (u.pm < 32 ? 1 : 2);
        const float* g = gate + cond * NMOD;
#pragma unroll
        for (int bj = 0; bj < 2; ++bj)
#pragma unroll
            for (int n = 0; n < 2; ++n) {
                const int c = u.pn * 256 + bj * 128 + wc * 32 + n * 16 + 4 * fq;
                f32x4 gv = *(const f32x4*)(g + c) * mult;
                if (cscale) gv = gv * *(const f32x4*)(cscale + c);
#pragma unroll
                for (int ai = 0; ai < 2; ++ai)
#pragma unroll
                    for (int m = 0; m < 4; ++m) {
                        const int row = u.pm * 256 + ai * 128 + wr * 64 + m * 16 + fr;
                        float* p = xy + (size_t)row * D + c;
                        const f32x4 x = *(const f32x4*)p;
                        *(f32x4*)p = x * ALPHA + gv * acc[ai][bj][m][n];
                    }
            }
    }
};
struct EpiQKV {
    static constexpr bool PERM = false, AFTER_DRAIN = false;
    bf16* Q; bf16* Kb; bf16* Vt; float* sk; float* sv; const float* cosT; const float* sinT;
    __device__ __forceinline__ void operator()(const f32x4 (&acc)[2][2][4][2], const pg8::Unit& u, int wr, int wc, int fr, int fq) const {
        const int pn = u.pn;
#pragma unroll
        for (int ai = 0; ai < 2; ++ai)
#pragma unroll
            for (int m = 0; m < 4; ++m) {
                const int row = u.pm * 256 + ai * 128 + wr * 64 + m * 16 + fr;
                const bool latent = row >= TP;
                const int pos = (row - TP) & 4095;
                const int gpos = (wc & 1) ? (pos & 63) : (pos >> 6);
#pragma unroll
                for (int bj = 0; bj < 2; ++bj) {
                    f32x4 a0 = acc[ai][bj][m][0], a1 = acc[ai][bj][m][1];
                    const int cl = bj * 128 + wc * 32 + 4 * fq;
                    if (pn < 5 && latent) {
                        const f32x4 cs = *(const f32x4*)(cosT + gpos * 16 + 4 * fq), sn = *(const f32x4*)(sinT + gpos * 16 + 4 * fq);
                        const f32x4 r0 = a0 * cs - a1 * sn, r1 = a1 * cs + a0 * sn; a0 = r0; a1 = r1;
                    }
                    v2u w0, w1; w0.x = pkbf(a0[0], a0[1]); w0.y = pkbf(a0[2], a0[3]); w1.x = pkbf(a1[0], a1[1]); w1.y = pkbf(a1[2], a1[3]);
                    if (pn < 4) {
                        bf16* q = Q + (size_t)row * D + pn * 256 + cl;
                        *(v2u*)q = w0; *(v2u*)(q + 16) = w1;
                    } else if (pn == 4) {
                        bf16* k = Kb + (size_t)row * 256 + cl;
                        *(v2u*)k = w0; *(v2u*)(k + 16) = w1;
                        if (!latent) { float* s = sk + (size_t)row * 256 + cl; *(f32x4*)s = a0; *(f32x4*)(s + 16) = a1; }
                    } else {
                        bf16* v = Vt + (size_t)cl * T + row;
                        v[0] = (bf16)(w0.x & 0xffffu); v[(size_t)T] = (bf16)(w0.x >> 16); v[(size_t)2 * T] = (bf16)(w0.y & 0xffffu); v[(size_t)3 * T] = (bf16)(w0.y >> 16);
                        v += (size_t)16 * T;
                        v[0] = (bf16)(w1.x & 0xffffu); v[(size_t)T] = (bf16)(w1.x >> 16); v[(size_t)2 * T] = (bf16)(w1.y & 0xffffu); v[(size_t)3 * T] = (bf16)(w1.y >> 16);
                        if (!latent) { float* s = sv + (size_t)row * 256 + cl; *(f32x4*)s = a0; *(f32x4*)(s + 16) = a1; }
                    }
                }
            }
    }
};

__device__ __forceinline__ void tr_item(const float* W, int ldw, int k0, int n0, bf16* WT, int ldwt, int orow0, int ocol0, LAS float* scr, int lane) {
#pragma unroll 8
    for (int i = 0; i < 32; ++i) { const int kk = 2 * i + (lane >> 5); scr[kk * 33 + (lane & 31)] = W[(size_t)(k0 + kk) * ldw + n0 + (lane & 31)]; }
    LDS_WAIT(); asm volatile("" ::: "memory");
    const int c = lane & 7;
#pragma unroll
    for (int j = 0; j < 4; ++j) { const int n = (lane >> 3) + 8 * j; const LAS float* s = scr + (8 * c) * 33 + n;
        v4u o; o.x = pkbf(s[0 * 33], s[1 * 33]); o.y = pkbf(s[2 * 33], s[3 * 33]); o.z = pkbf(s[4 * 33], s[5 * 33]); o.w = pkbf(s[6 * 33], s[7 * 33]);
        *(v4u*)(WT + (size_t)(orow0 + n) * ldwt + ocol0 + k0 + 8 * c) = o; }
    LDS_WAIT(); asm volatile("" ::: "memory");
}
__device__ __forceinline__ void modv_item(const float* w_mod, const float* c, const float* c_ctx, float* part, int r, int lane) {
    const int l = r / 576, q = r % 576, nb = q / 16, kc = q % 16;
    const int k0 = kc * 64, n = nb * 256 + 4 * lane;
    const float s0 = silu_f(c_ctx[k0 + lane]), s1 = silu_f(c[k0 + lane]), s2 = silu_f(c[1024 + k0 + lane]);
    const float* W = w_mod + ((size_t)l * 1024 + k0) * NMOD + n;
    f32x4 a0 = {0.f, 0.f, 0.f, 0.f}, a1 = a0, a2 = a0;
#pragma unroll 16
    for (int kk = 0; kk < 64; ++kk) {
        const f32x4 w = __builtin_nontemporal_load((const f32x4*)(W + (size_t)kk * NMOD));
        const float t0 = __shfl(s0, kk), t1 = __shfl(s1, kk), t2 = __shfl(s2, kk);
        a0 += w * t0; a1 += w * t1; a2 += w * t2;
    }
    float* P = part + ((size_t)(kc * 2 + l) * 3) * NMOD + n;
    *(f32x4*)P = a0; *(f32x4*)(P + NMOD) = a1; *(f32x4*)(P + 2 * NMOD) = a2;
}

constexpr int I_MODV = 2 * 36 * 16, I_GU = 4 * 2 * 1408, I_DN = 4 * 1408, I_QKV = 16 * 48, I_WO = 16 * 32, I_POOL = 128, I_PZ = 1024, I_CV = 64, I_CK = 64, I_ROPE = 1;
constexpr int NITEMS = I_MODV + I_GU + I_DN + I_QKV + I_WO + I_POOL + I_PZ + I_CV + I_CK + I_ROPE;

__device__ __forceinline__ void p0a_phase(const Args& a, LAS unsigned char* ldsp, int gw, int NGW, int wave, int lane) {
    LAS float* scr = (LAS float*)(ldsp + wave * 16384);
    unsigned char* ws = a.ws;
    for (int it = gw; it < NITEMS; it += NGW) {
        int r = it;
        if (r < I_MODV) { modv_item(a.in[6], a.in[4], a.in[5], (float*)(ws + WS_PART), r, lane); continue; } r -= I_MODV;
        if (r < I_GU) { const int lj = r / 2816, rr = r % 2816, up = rr / 1408, q = rr % 1408, kb = q / 88, nb = q % 88, n0 = 32 * nb;
            tr_item((up ? a.in[11] : a.in[10]) + (size_t)lj * D * FF, FF, 64 * kb, n0, (bf16*)(ws + WS_WGU) + (size_t)lj * NGU * D, D, 256 * (n0 / 128) + (n0 % 128) + (up ? 128 : 0), 0, scr, lane); continue; } r -= I_GU;
        if (r < I_DN) { const int lj = r / 1408, q = r % 1408, kb = q / 32, nb = q % 32;
            tr_item(a.in[12] + (size_t)lj * FF * D, D, 64 * kb, 32 * nb, (bf16*)(ws + WS_WD) + (size_t)lj * D * FF, FF, 32 * nb, 0, scr, lane); continue; } r -= I_DN;
        if (r < I_QKV) { const int kb = r / 48, nb = r % 48; tr_item(a.in[13], NQKV, 64 * kb, 32 * nb, (bf16*)(ws + WS_WQKV), D, 32 * nb, 0, scr, lane); continue; } r -= I_QKV;
        if (r < I_WO) { const int kb = r / 32, nb = r % 32; tr_item(a.in[14], D, 64 * kb, 32 * nb, (bf16*)(ws + WS_WO), D, 32 * nb, 0, scr, lane); continue; } r -= I_WO;
        if (r < I_POOL) { const int g = r / 32, rr = r % 32, kb = rr / 8, nb = rr % 8;
            tr_item(a.in[16] + (size_t)g * 65536, 256, 64 * kb, 32 * nb, (bf16*)(ws + WS_WP), D, 256 * g + 32 * nb, 256 * g, scr, lane); continue; } r -= I_POOL;
        if (r < I_PZ) { bf16* row = (bf16*)(ws + WS_WP) + (size_t)r * D; const int g = r >> 8;
#pragma unroll
            for (int i = 0; i < 2; ++i) { const int ch = lane + 64 * i; if (((8 * ch) >> 8) != g) *(v4u*)(row + 8 * ch) = (v4u){0u, 0u, 0u, 0u}; }
            continue; } r -= I_PZ;
        if (r < I_CV) { const int b = r / 32, rr = r % 32, kb = rr / 8, nb = rr % 8;
            tr_item(a.in[3] + (size_t)b * 65536, 256, 64 * kb, 32 * nb, (bf16*)(ws + WS_VCT) + (size_t)b * 65536, 256, 32 * nb, 0, scr, lane); continue; } r -= I_CV;
        if (r < I_CK) { const float* src = a.in[2] + (size_t)r * 2048; bf16* dst = (bf16*)(ws + WS_KC) + (size_t)r * 2048;
#pragma unroll
            for (int i = 0; i < 4; ++i) { const int idx = i * 512 + lane * 8; const f32x4 x = *(const f32x4*)(src + idx), y = *(const f32x4*)(src + idx + 4);
                v4u o; o.x = pkbf(x[0], x[1]); o.y = pkbf(x[2], x[3]); o.z = pkbf(y[0], y[1]); o.w = pkbf(y[2], y[3]); *(v4u*)(dst + idx) = o; }
            continue; } r -= I_CK;
        { float* cosT = (float*)(ws + WS_ROPE); float* sinT = cosT + 1024;
#pragma unroll 1
            for (int f = 0; f < 16; ++f) { const float inv = exp2f(-(float)f * (13.287712379549449f / 16.f)); const float ang = (float)lane * inv;
                cosT[lane * 16 + f] = cosf(ang); sinT[lane * 16 + f] = sinf(ang); } }
    }
}
__device__ __forceinline__ void p0b_phase(const Args& a, int gtid, int NT) {
    const float* part = (const float*)(a.ws + WS_PART); float* modv = (float*)(a.ws + WS_MODV); const float* b_mod = a.in[7];
    for (int i = gtid; i < 2 * 3 * (NMOD / 4); i += NT) {
        const int l = i / 6912, rem = i % 6912, cond = rem / 2304, n = 4 * (rem % 2304);
        f32x4 s = *(const f32x4*)(b_mod + l * NMOD + n);
#pragma unroll
        for (int kc = 0; kc < 16; ++kc) s += *(const f32x4*)(part + ((size_t)(kc * 2 + l) * 3 + cond) * NMOD + n);
        *(f32x4*)(modv + (size_t)(l * 3 + cond) * NMOD + n) = s;
    }
}

__device__ __forceinline__ void ln_phase(int mode, const float* xin_p, const float* xin_s, float* xy, bf16* H, const float* g, const float* b,
                                         const float* modl, int ishift, int iscale, int gw, int NGW, int lane) {
    for (int r = gw; r < T; r += NGW) {
        const int cond = r < TP ? 0 : (r < 2 * TP ? 1 : 2);
        const float* src = (mode == 0) ? (r < TP ? xin_p + (size_t)r * D : xin_s + (size_t)(r - TP) * D) : xy + (size_t)r * D;
        f32x4 v[4];
#pragma unroll
        for (int j = 0; j < 4; ++j) v[j] = *(const f32x4*)(src + 256 * j + 4 * lane);
        if (mode != 0) {
            float s = 0.f;
#pragma unroll
            for (int j = 0; j < 4; ++j) s += (v[j][0] + v[j][1]) + (v[j][2] + v[j][3]);
            const float mean = wave_sum(s) * (1.f / D); float s2 = 0.f;
#pragma unroll
            for (int j = 0; j < 4; ++j) { v[j] = v[j] - mean; s2 += (v[j][0] * v[j][0] + v[j][1] * v[j][1]) + (v[j][2] * v[j][2] + v[j][3] * v[j][3]); }
            const float rstd = 1.f / sqrtf(wave_sum(s2) * (1.f / D) + LN_EPS);
#pragma unroll
            for (int j = 0; j < 4; ++j) v[j] = v[j] * rstd * *(const f32x4*)(g + 256 * j + 4 * lane) + *(const f32x4*)(b + 256 * j + 4 * lane);
        }
#pragma unroll
        for (int j = 0; j < 4; ++j) *(f32x4*)(xy + (size_t)r * D + 256 * j + 4 * lane) = v[j];
        if (mode != 2) {
            const float* sh = modl + cond * NMOD + ishift * D; const float* sc = modl + cond * NMOD + iscale * D;
#pragma unroll
            for (int j = 0; j < 4; ++j) { const f32x4 h = v[j] * (*(const f32x4*)(sc + 256 * j + 4 * lane) + 1.f) + *(const f32x4*)(sh + 256 * j + 4 * lane);
                v2u w; w.x = pkbf(h[0], h[1]); w.y = pkbf(h[2], h[3]); *(v2u*)(H + (size_t)r * D + 256 * j + 4 * lane) = w; }
        }
    }
}
__device__ __forceinline__ void pool_phase(const float* xy, bf16* P, const float* modl, int iscale, int gw, int NGW, int lane) {
    for (int r = gw; r < T; r += NGW) {
        const int cond = r < TP ? 0 : (r < 2 * TP ? 1 : 2);
        const int s0 = r < TP ? (r & ~255) : (TP + ((r - TP) & ~4095)), L = r < TP ? 256 : 4096, pos = r - s0;
        const float* sc = modl + cond * NMOD + iscale * D;
#pragma unroll
        for (int j = 0; j < 4; ++j) {
            const int hw = 1 << j, lo = max(pos - hw, 0), hi = min(pos + hw, L);
            f32x4 sum = {0.f, 0.f, 0.f, 0.f};
            for (int jj = lo; jj < hi; ++jj) sum += *(const f32x4*)(xy + (size_t)(s0 + jj) * D + 256 * j + 4 * lane);
            const f32x4 ctr = *(const f32x4*)(xy + (size_t)r * D + 256 * j + 4 * lane);
            const float cnt = (float)(hi - lo);
            f32x4 pl; pl[0] = sum[0] / cnt - ctr[0]; pl[1] = sum[1] / cnt - ctr[1]; pl[2] = sum[2] / cnt - ctr[2]; pl[3] = sum[3] / cnt - ctr[3];
            pl = pl * (*(const f32x4*)(sc + 256 * j + 4 * lane) + 1.f);
            v2u w; w.x = pkbf(pl[0], pl[1]); w.y = pkbf(pl[2], pl[3]); *(v2u*)(P + (size_t)r * D + 256 * j + 4 * lane) = w;
        }
    }
}

struct AttnState { float m[4], l[4]; f32x4 o[4][4]; };
template <bool MASK>
__device__ __forceinline__ void attn_tiles(AttnState& st, const bf16x8 (&qf)[4][2], const bf16* Kp, const bf16* Vp, int ldv, int kbeg, int kend, int qpos, int fr, int fq) {
    constexpr float SC = 0.125f * LOG2E;
    for (int ks = kbeg; ks < kend; ks += 32) {
        bf16x8 kf[2][2]; bf16x8 vf[4];
#pragma unroll
        for (int s = 0; s < 2; ++s)
#pragma unroll
            for (int dc = 0; dc < 2; ++dc) kf[s][dc] = *(const bf16x8*)(Kp + (size_t)(ks + 16 * s + fr) * 256 + dc * 32 + fq * 8);
#pragma unroll
        for (int dd = 0; dd < 4; ++dd) { const bf16* vp = Vp + (size_t)(16 * dd + fr) * ldv + ks + 4 * fq; const s16x4 lo = *(const s16x4*)vp, hi = *(const s16x4*)(vp + 16);
            vf[dd] = (bf16x8){lo[0], lo[1], lo[2], lo[3], hi[0], hi[1], hi[2], hi[3]}; }
#pragma unroll
        for (int hh = 0; hh < 4; ++hh) {
            f32x4 s0 = {0.f, 0.f, 0.f, 0.f}, s1 = s0;
            s0 = __builtin_amdgcn_mfma_f32_16x16x32_bf16(kf[0][0], qf[hh][0], s0, 0, 0, 0); s0 = __builtin_amdgcn_mfma_f32_16x16x32_bf16(kf[0][1], qf[hh][1], s0, 0, 0, 0);
            s1 = __builtin_amdgcn_mfma_f32_16x16x32_bf16(kf[1][0], qf[hh][0], s1, 0, 0, 0); s1 = __builtin_amdgcn_mfma_f32_16x16x32_bf16(kf[1][1], qf[hh][1], s1, 0, 0, 0);
            s0 = s0 * SC; s1 = s1 * SC;
            if (MASK) {
#pragma unroll
                for (int e = 0; e < 4; ++e) { const int k0 = ks + 4 * fq + e, d0 = qpos - k0, d1 = d0 - 16;
                    if (d0 > 128 || d0 < -128) s0[e] = -1e30f; if (d1 > 128 || d1 < -128) s1[e] = -1e30f; }
            }
            float rm = fmaxf(fmaxf(fmaxf(s0[0], s0[1]), fmaxf(s0[2], s0[3])), fmaxf(fmaxf(s1[0], s1[1]), fmaxf(s1[2], s1[3])));
            rm = fmaxf(rm, __shfl_xor(rm, 16)); rm = fmaxf(rm, __shfl_xor(rm, 32));
            const float mn = fmaxf(st.m[hh], rm), f = __builtin_amdgcn_exp2f(st.m[hh] - mn); st.m[hh] = mn;
            float p[8];
#pragma unroll
            for (int e = 0; e < 4; ++e) { p[e] = __builtin_amdgcn_exp2f(s0[e] - mn); p[4 + e] = __builtin_amdgcn_exp2f(s1[e] - mn); }
            st.l[hh] = st.l[hh] * f + ((p[0] + p[1]) + (p[2] + p[3])) + ((p[4] + p[5]) + (p[6] + p[7]));
            v4u pw; pw.x = pkbf(p[0], p[1]); pw.y = pkbf(p[2], p[3]); pw.z = pkbf(p[4], p[5]); pw.w = pkbf(p[6], p[7]);
            const bf16x8 pf = __builtin_bit_cast(bf16x8, pw);
#pragma unroll
            for (int dd = 0; dd < 4; ++dd) { st.o[hh][dd] = st.o[hh][dd] * f; st.o[hh][dd] = __builtin_amdgcn_mfma_f32_16x16x32_bf16(vf[dd], pf, st.o[hh][dd], 0, 0, 0); }
        }
    }
}
__device__ __forceinline__ void attn_phase(const bf16* Q, const bf16* Kb, const bf16* Vt, const bf16* Kc, const bf16* Vct, bf16* O, const float* sink, int gw, int NGW, int lane) {
    const int fr = lane & 15, fq = lane >> 4;
    for (int item = gw; item < 3072; item += NGW) {
        int seqbase, kvh, t0, b; const bool latent = item < 2048;
        if (latent) { b = item >> 10; kvh = (item >> 8) & 3; t0 = (item & 255) * 16; seqbase = TP + b * 4096; }
        else { const int it = item - 2048; b = it >> 6; kvh = (it >> 4) & 3; t0 = (it & 15) * 16; seqbase = b * 256; }
        bf16x8 qf[4][2];
#pragma unroll
        for (int hh = 0; hh < 4; ++hh)
#pragma unroll
            for (int dc = 0; dc < 2; ++dc) qf[hh][dc] = *(const bf16x8*)(Q + (size_t)(seqbase + t0 + fr) * D + (kvh * 4 + hh) * 64 + dc * 32 + fq * 8);
        AttnState st;
#pragma unroll
        for (int hh = 0; hh < 4; ++hh) { st.m[hh] = sink[kvh * 4 + hh] * LOG2E; st.l[hh] = (fq == 0) ? 1.f : 0.f;
#pragma unroll
            for (int dd = 0; dd < 4; ++dd) st.o[hh][dd] = (f32x4){0.f, 0.f, 0.f, 0.f}; }
        const bf16* Kp = Kb + (size_t)seqbase * 256 + kvh * 64; const bf16* Vp = Vt + (size_t)(kvh * 64) * T + seqbase;
        if (latent) {
            const int kb = max(0, t0 - 128) & ~31, ke = min(4096, t0 + 144);
            attn_tiles<true>(st, qf, Kp, Vp, T, kb, ke, t0 + fr, fr, fq);
            attn_tiles<false>(st, qf, Kc + (size_t)b * 65536 + kvh * 64, Vct + (size_t)b * 65536 + (size_t)(kvh * 64) * 256, 256, 0, 256, 0, fr, fq);
        } else {
            attn_tiles<false>(st, qf, Kp, Vp, T, 0, 256, 0, fr, fq);
        }
#pragma unroll
        for (int hh = 0; hh < 4; ++hh) {
            float l = st.l[hh]; l += __shfl_xor(l, 16); l += __shfl_xor(l, 32);
            const float inv = 1.f / l;
            bf16* op = O + (size_t)(seqbase + t0 + fr) * D + (kvh * 4 + hh) * 64 + 4 * fq;
#pragma unroll
            for (int dd = 0; dd < 4; ++dd) { const f32x4 o = st.o[hh][dd] * inv; v2u w; w.x = pkbf(o[0], o[1]); w.y = pkbf(o[2], o[3]); *(v2u*)(op + 16 * dd) = w; }
        }
    }
}

enum { K_P0A = 0, K_P0B, K_LN, K_UP, K_RES, K_QKV, K_ATT, K_POOL };

__global__ void __launch_bounds__(NWAVES * 64, 2) mk_fwd(Args args) {
    extern __shared__ __attribute__((aligned(16))) unsigned char lds[];
    LAS unsigned char* ldsp = (LAS unsigned char*)lds;
    const int tid = threadIdx.x, lane = tid & 63, wave = __builtin_amdgcn_readfirstlane(tid >> 6);
    const int G = gridDim.x, gw = blockIdx.x * NWAVES + wave, NGW = G * NWAVES;
    unsigned char* ws = args.ws;
    float* xy = args.out;
    float* sk = args.out + (size_t)T * D; float* sv = sk + (size_t)TP * 256;
    float* modv = (float*)(ws + WS_MODV);
    bf16* H = (bf16*)(ws + WS_H); bf16* A = (bf16*)(ws + WS_A); bf16* Qb = (bf16*)(ws + WS_Q); bf16* Ob = (bf16*)(ws + WS_O);
    bf16* Kb = (bf16*)(ws + WS_KB); bf16* Vt = (bf16*)(ws + WS_VT);

    const int lo = args.ph_lo, hi = args.ph_hi;
#define IN(k) (lo <= (k) && (k) < hi)
#define SEAM(k) do { if ((k) + 1 < hi) cg::this_grid().sync(); } while (0)
#define MODL(l) (modv + (size_t)(l) * 3 * NMOD)
#define PH_LN(k, mode, lnidx, l, mi) if (IN(k)) { ln_phase(mode, args.in[0], args.in[1], xy, H, args.in[8] + (lnidx) * D, args.in[9] + (lnidx) * D, MODL(l), mi, (mi) + 1, gw, NGW, lane); SEAM(k); }
#define PH_UP(k, lj) if (IN(k)) { pg8::Gemm g{H, (const bf16*)(ws + WS_WGU) + (size_t)(lj) * NGU * D, T, NGU, D}; pg8::StaticOrder S; S.init(T, NGU, G, (int)blockIdx.x); \
        EpiSwiglu E{A}; pg8::gemm_phase<EpiSwiglu, pg8::StaticOrder, true, true>(ldsp, g, S, E); SEAM(k); }
#define PH_DOWN(k, lj, l, gi) if (IN(k)) { pg8::Gemm g{A, (const bf16*)(ws + WS_WD) + (size_t)(lj) * D * FF, T, D, FF}; pg8::StaticOrder S; S.init(T, D, G, (int)blockIdx.x); \
        EpiResid E{xy, MODL(l) + (gi) * D, nullptr, 0.5f}; pg8::gemm_phase<EpiResid, pg8::StaticOrder, true, true>(ldsp, g, S, E); SEAM(k); }
#define PH_RESD(k, Ap, Wp, l, gi, cs) if (IN(k)) { pg8::Gemm g{Ap, (const bf16*)(ws + (Wp)), T, D, D}; pg8::StaticOrder S; S.init(T, D, G, (int)blockIdx.x); \
        EpiResid E{xy, MODL(l) + (gi) * D, cs, 1.0f}; pg8::gemm_phase<EpiResid, pg8::StaticOrder, true, true>(ldsp, g, S, E); SEAM(k); }

    if (IN(0)) { p0a_phase(args, ldsp, gw, NGW, wave, lane); SEAM(0); }
    if (IN(1)) { p0b_phase(args, blockIdx.x * (NWAVES * 64) + tid, G * NWAVES * 64); SEAM(1); }
    PH_LN(2, 0, 0, 0, 0)
    PH_UP(3, 0)
    PH_DOWN(4, 0, 0, 2)
    PH_LN(5, 1, 0, 0, 3)
    if (IN(6)) { pg8::Gemm g{H, (const bf16*)(ws + WS_WQKV), T, NQKV, D}; pg8::StaticOrder S; S.init(T, NQKV, G, (int)blockIdx.x);
        EpiQKV E{Qb, Kb, Vt, sk, sv, (const float*)(ws + WS_ROPE), (const float*)(ws + WS_ROPE) + 1024};
        pg8::gemm_phase<EpiQKV, pg8::StaticOrder, true, true>(ldsp, g, S, E); SEAM(6); }
    if (IN(7)) { attn_phase(Qb, Kb, Vt, (const bf16*)(ws + WS_KC), (const bf16*)(ws + WS_VCT), Ob, args.in[15], gw, NGW, lane); SEAM(7); }
    PH_RESD(8, Ob, WS_WO, 0, 5, nullptr)
    PH_LN(9, 1, 1, 0, 6)
    PH_UP(10, 1)
    PH_DOWN(11, 1, 0, 8)
    PH_LN(12, 1, 2, 1, 0)
    PH_UP(13, 2)
    PH_DOWN(14, 2, 1, 2)
    PH_LN(15, 2, 3, 1, 0)
    if (IN(16)) { pool_phase(xy, H, MODL(1), 4, gw, NGW, lane); SEAM(16); }
    PH_RESD(17, H, WS_WP, 1, 5, args.in[17])
    PH_LN(18, 1, 4, 1, 6)
    PH_UP(19, 3)
    PH_DOWN(20, 3, 1, 8)
    PH_LN(21, 2, 5, 1, 0)
#undef IN
#undef SEAM
}

extern "C" void kernel_launch(void* const* d_in, const int* in_sizes, int n_in, void* d_out, int out_size, void* d_ws, size_t ws_size, hipStream_t stream) {
    static int grid = 0;
    if (grid == 0) {
        if (n_in != 18 || ws_size < WS_END) { fprintf(stderr, "kernel_launch: unexpected inputs (n_in %d, ws %zu)\n", n_in, ws_size); grid = -1; return; }
        int dev = 0, cus = 0, per_cu = 0;
        hipGetDevice(&dev); hipDeviceGetAttribute(&cus, hipDeviceAttributeMultiprocessorCount, dev);
        if (hipFuncSetAttribute((const void*)mk_fwd, hipFuncAttributeMaxDynamicSharedMemorySize, LDS_BYTES) != hipSuccess) { fprintf(stderr, "kernel_launch: hipFuncSetAttribute failed\n"); grid = -1; return; }
        if (hipOccupancyMaxActiveBlocksPerMultiprocessor(&per_cu, (const void*)mk_fwd, NWAVES * 64, LDS_BYTES) != hipSuccess || per_cu < 1) { fprintf(stderr, "kernel_launch: occupancy query says %d\n", per_cu); per_cu = 1; }
        (void)hipGetLastError();
        grid = cus * 1;
        if (grid <= 0) grid = 256;
    }
    if (grid < 0) return;
    Args a{};
    for (int i = 0; i < 18; ++i) a.in[i] = (const float*)d_in[i];
    a.out = (float*)d_out; a.ws = (unsigned char*)d_ws;
#if MK_PER_PHASE
    for (int ph = 0; ph < N_PHASES; ++ph) { a.ph_lo = ph; a.ph_hi = ph + 1; hipLaunchKernelGGL(mk_fwd, dim3(grid), dim3(NWAVES * 64), LDS_BYTES, stream, a); }
#else
    a.ph_lo = 0; a.ph_hi = N_PHASES;
    void* kargs[] = {&a};
    hipError_t e = hipLaunchCooperativeKernel((const void*)mk_fwd, dim3(grid), dim3(NWAVES * 64), kargs, LDS_BYTES, stream);
    if (e != hipSuccess) fprintf(stderr, "kernel_launch: cooperative launch failed: %s (grid %d)\n", hipGetErrorString(e), grid);
#endif
}
```

```cpp
#include <hip/hip_runtime.h>
#include <hip/hip_cooperative_groups.h>
#include <cstdio>
#include <cstdint>
#ifndef MK_PER_PHASE
#define MK_PER_PHASE 0
#endif
namespace pg8 {
#define PG8_LAS __attribute__((address_space(3)))
typedef unsigned short bf16_t;
typedef short bf16x8 __attribute__((ext_vector_type(8)));
typedef float f32x4 __attribute__((ext_vector_type(4)));
typedef unsigned u32x4 __attribute__((ext_vector_type(4)));
constexpr int BM = 256, BK = 64, HALF = 128, HTB = HALF * BK * 2  , STAGE_BYTES = 8 * HTB, NXCD = 8, WGM = 8;

__host__ __device__ __forceinline__ int lds_byte(int r, int c) { const int st = (r >> 4) * 2 + (c >> 5), rr = r & 15, cc = c & 31, ob = rr * 64 + cc * 2; return st * 1024 + (ob ^ (((ob >> 9) & 1) << 5)); }
__host__ __device__ __forceinline__ void stage_rc(int b, int& R, int& C) { const int st = b / 1024, sb = b % 1024, swz = sb ^ (((sb >> 9) & 1) << 5); R = (st >> 1) * 16 + swz / 64; C = (st & 1) * 32 + (swz % 64) / 2; }
__host__ __device__ __forceinline__ int perm32(int rho) { const int n = rho >> 4, i = rho & 15; return 8 * (i >> 2) + 4 * n + (i & 3); }

struct Unit { int pm, pn; };
struct Gemm { const bf16_t* A; const bf16_t* Bt; int M, N, K; };

struct StaticOrder {
    int nM, nN, nwg, G, c;
    __host__ __device__ void init(int M, int N, int G_, int c_) { nM = M / BM; nN = N / BM; nwg = nM * nN; G = G_; c = c_; }
    __host__ __device__ bool next(int i, Unit& u) const {
        const long L = (long)i * G + c; if (L >= nwg) return false;
        int wgid = (int)L; { const int q = nwg / NXCD, r = nwg % NXCD, xcd = wgid % NXCD, off = wgid / NXCD; wgid = (xcd < r ? xcd * (q + 1) : r * (q + 1) + (xcd - r) * q) + off; }
        const int nig = WGM * nN, gid = wgid / nig, fm = gid * WGM, gsz = (nM - fm) < WGM ? (nM - fm) : WGM;
        u.pm = fm + ((wgid % nig) % gsz); u.pn = (wgid % nig) / gsz; return true;
    }
    __device__ __forceinline__ void a_ready(const Unit&) const {}
    __device__ __forceinline__ void done(const Unit&) const {}
};

__device__ __forceinline__ unsigned cvt_pk_bf16(float lo, float hi) { unsigned r; asm volatile("v_cvt_pk_bf16_f32 %0, %1, %2" : "=v"(r) : "v"(lo), "v"(hi)); return r; }
__device__ __forceinline__ void mfma8(f32x4& c, bf16x8 a0, bf16x8 a1, bf16x8 b0, bf16x8 b1) {
    typedef int i32x4 __attribute__((ext_vector_type(4))); typedef int i32x8 __attribute__((ext_vector_type(8)));
    const i32x8 a = __builtin_shufflevector(__builtin_bit_cast(i32x4, a0), __builtin_bit_cast(i32x4, a1), 0, 1, 2, 3, 4, 5, 6, 7);
    const i32x8 b = __builtin_shufflevector(__builtin_bit_cast(i32x4, b0), __builtin_bit_cast(i32x4, b1), 0, 1, 2, 3, 4, 5, 6, 7);
    asm volatile("v_mfma_f32_16x16x128_f8f6f4 %0, %1, %2, %0" : "+v"(c) : "v"(a), "v"(b));
}
template <class Epi, class Sched, bool ALIGN_EPI = false, bool SP2 = false, bool F8 = false>
__device__ __forceinline__ void gemm_phase(PG8_LAS unsigned char* lds, const Gemm g, const Sched& S, const Epi& E) {
    const int tid = threadIdx.x, wid = __builtin_amdgcn_readfirstlane(tid >> 6), lane = tid & 63, wr = wid >> 2, wc = wid & 3, fr = lane & 15, fq = lane >> 4;
    const int K = g.K, nt = K / BK;
    unsigned voffA[2], voffB[2];
#pragma unroll
    for (int i = 0; i < 2; ++i) { int R, C; stage_rc(tid * 16 + i * 8192, R, C); const int Rb = Epi::PERM ? ((R & ~31) + perm32(R & 31)) : R;
        voffA[i] = (unsigned)(R * K + C) * 2u; voffB[i] = (unsigned)(Rb * K + C) * 2u; }
    const size_t kstep = (size_t)(BK * 2);
    const size_t hstep = (size_t)HALF * K * 2;
    const size_t tstep = 2 * hstep;
    const unsigned ldsw = (unsigned)wid * 1024u;
    const int aoff = lds_byte(wr * 64 + fr, fq * 8), boff = lds_byte(wc * 32 + fr, fq * 8);
#define PG8_SA(b, h) (((b) * 2 + (h)) * HTB)
#define PG8_SB(b, h) ((4 + (b) * 2 + (h)) * HTB)
#define PG8_STAGE(bufoff, gbase, voff) do { _Pragma("unroll") for (int _i = 0; _i < 2; ++_i) \
        __builtin_amdgcn_global_load_lds((const unsigned*)((const char*)(gbase) + (voff)[_i]), (PG8_LAS unsigned*)(lds + (bufoff) + ldsw + _i * 8192), 16, 0, 0); } while (0)
#define PG8_LDA(dst, b, h) do { _Pragma("unroll") for (int m = 0; m < 4; ++m) _Pragma("unroll") for (int k = 0; k < 2; ++k) dst[m][k] = *(const PG8_LAS bf16x8*)(lds + PG8_SA(b, h) + aoff + m * 2048 + k * 1024); } while (0)
#define PG8_LDB(dst, b, h) do { _Pragma("unroll") for (int n = 0; n < 2; ++n) _Pragma("unroll") for (int k = 0; k < 2; ++k) dst[n][k] = *(const PG8_LAS bf16x8*)(lds + PG8_SB(b, h) + boff + n * 2048 + k * 1024); } while (0)
#define PG8_MMA(ai, bj, At, Bt) do { __builtin_amdgcn_s_setprio(1); _Pragma("unroll") for (int m = 0; m < 4; ++m) _Pragma("unroll") for (int n = 0; n < 2; ++n) { \
        if constexpr (F8) { mfma8(acc[ai][bj][m][n], Bt[n][0], Bt[n][1], At[m][0], At[m][1]); } \
        else { _Pragma("unroll") for (int k = 0; k < 2; ++k) acc[ai][bj][m][n] = __builtin_amdgcn_mfma_f32_16x16x32_bf16(Bt[n][k], At[m][k], acc[ai][bj][m][n], 0, 0, 0); } } \
        __builtin_amdgcn_s_setprio(0); } while (0)
#define PG8_WAIT_V(n) asm volatile("s_waitcnt vmcnt(" #n ")" ::: "memory")
#define PG8_WAIT_L(n) asm volatile("s_waitcnt lgkmcnt(" #n ")" ::: "memory")
#define PG8_BAR __builtin_amdgcn_s_barrier()
#define PG8_SCHED __builtin_amdgcn_sched_barrier(0)
    Unit cur, nxt; int ui = 0;
    if (!S.next(0, cur)) return;
    f32x4 acc[2][2][4][2];
#pragma unroll
    for (int a = 0; a < 2; ++a)
#pragma unroll
        for (int b = 0; b < 2; ++b)
#pragma unroll
            for (int m = 0; m < 4; ++m)
#pragma unroll
                for (int n = 0; n < 2; ++n) acc[a][b][m][n] = (f32x4){0.f, 0.f, 0.f, 0.f};
    bf16x8 At[4][2], B0[2][2], B1[2][2];
    const char* cA = (const char*)g.A + (size_t)cur.pm * tstep; const char* cB = (const char*)g.Bt + (size_t)cur.pn * tstep;
    S.a_ready(cur);
    if constexpr (SP2) {
        PG8_STAGE(PG8_SB(0, 0), cB, voffB); PG8_STAGE(PG8_SB(0, 1), cB + hstep, voffB); PG8_STAGE(PG8_SA(0, 0), cA, voffA); PG8_STAGE(PG8_SA(0, 1), cA + hstep, voffA);
        if (wr == 1) PG8_BAR;
        PG8_WAIT_V(2); PG8_BAR;
        PG8_STAGE(PG8_SB(1, 0), cB + kstep, voffB); PG8_STAGE(PG8_SA(1, 0), cA + kstep, voffA); PG8_STAGE(PG8_SB(1, 1), cB + hstep + kstep, voffB);
        PG8_WAIT_V(6); PG8_BAR;
    } else {
        PG8_STAGE(PG8_SB(0, 0), cB, voffB); PG8_STAGE(PG8_SA(0, 0), cA, voffA); PG8_STAGE(PG8_SB(0, 1), cB + hstep, voffB); PG8_STAGE(PG8_SA(0, 1), cA + hstep, voffA);
        if (wr == 1) PG8_BAR;
        PG8_WAIT_V(4); PG8_BAR;
        PG8_STAGE(PG8_SB(1, 0), cB + kstep, voffB); PG8_STAGE(PG8_SA(1, 0), cA + kstep, voffA); PG8_STAGE(PG8_SB(1, 1), cB + hstep + kstep, voffB);
        PG8_WAIT_V(6); PG8_BAR;
    }
    for (;;) {
        const bool has_next = S.next(ui + 1, nxt);
        const char* nA = has_next ? (const char*)g.A + (size_t)nxt.pm * tstep : cA; const char* nB = has_next ? (const char*)g.Bt + (size_t)nxt.pn * tstep : cB;
        for (int t = 0; t < nt; t += 2) {
            const bool last = (t == nt - 2);
            const char* a1 = cA + (size_t)(t + 1) * kstep;
            const char* a2 = last ? nA : cA + (size_t)(t + 2) * kstep; const char* b2 = last ? nB : cB + (size_t)(t + 2) * kstep;
            const char* a3 = a2 + kstep; const char* b3 = b2 + kstep;
            if (last && has_next) S.a_ready(nxt);
            if constexpr (SP2) {
            PG8_LDB(B0, 0, 0); PG8_LDB(B1, 0, 1); PG8_SCHED; PG8_LDA(At, 0, 0); PG8_STAGE(PG8_SA(1, 1), a1 + hstep, voffA);
            PG8_WAIT_V(8); PG8_WAIT_L(0); PG8_BAR; PG8_MMA(0, 0, At, B0); PG8_MMA(0, 1, At, B1); PG8_BAR; PG8_SCHED;
            PG8_LDA(At, 0, 1); PG8_STAGE(PG8_SB(0, 0), b2, voffB); PG8_STAGE(PG8_SB(0, 1), b2 + hstep, voffB); PG8_STAGE(PG8_SA(0, 0), a2, voffA);
            PG8_WAIT_V(8); PG8_WAIT_L(0); PG8_BAR; PG8_MMA(1, 0, At, B0); PG8_MMA(1, 1, At, B1); PG8_BAR; PG8_SCHED;
            PG8_LDB(B0, 1, 0); PG8_LDB(B1, 1, 1); PG8_SCHED; PG8_LDA(At, 1, 0); PG8_STAGE(PG8_SA(0, 1), a2 + hstep, voffA);
            PG8_WAIT_V(8); PG8_WAIT_L(0); PG8_BAR; PG8_MMA(0, 0, At, B0); PG8_MMA(0, 1, At, B1); PG8_BAR; PG8_SCHED;
            PG8_LDA(At, 1, 1); PG8_STAGE(PG8_SB(1, 0), b3, voffB); PG8_STAGE(PG8_SB(1, 1), b3 + hstep, voffB); PG8_STAGE(PG8_SA(1, 0), a3, voffA);
            PG8_WAIT_V(8); PG8_WAIT_L(0); PG8_BAR; PG8_MMA(1, 0, At, B0); PG8_MMA(1, 1, At, B1); PG8_BAR; PG8_SCHED;
            } else {
            PG8_LDB(B0, 0, 0); PG8_SCHED; PG8_LDA(At, 0, 0); PG8_STAGE(PG8_SA(1, 1), a1 + hstep, voffA);
            PG8_WAIT_L(8); PG8_BAR; PG8_WAIT_L(0); PG8_MMA(0, 0, At, B0); PG8_BAR; PG8_SCHED;
            PG8_LDB(B1, 0, 1); PG8_STAGE(PG8_SB(0, 0), b2, voffB);
            PG8_BAR; PG8_WAIT_L(0); PG8_MMA(0, 1, At, B1); PG8_BAR;
            PG8_LDA(At, 0, 1); PG8_STAGE(PG8_SA(0, 0), a2, voffA);
            PG8_BAR; PG8_WAIT_L(0); PG8_MMA(1, 0, At, B0); PG8_BAR; PG8_SCHED;
            PG8_STAGE(PG8_SB(0, 1), b2 + hstep, voffB);
            PG8_WAIT_V(6); PG8_BAR; PG8_MMA(1, 1, At, B1); PG8_BAR;
            PG8_LDB(B0, 1, 0); PG8_SCHED; PG8_LDA(At, 1, 0); PG8_STAGE(PG8_SA(0, 1), a2 + hstep, voffA);
            PG8_WAIT_L(8); PG8_BAR; PG8_WAIT_L(0); PG8_MMA(0, 0, At, B0); PG8_BAR; PG8_SCHED;
            PG8_LDB(B1, 1, 1); PG8_STAGE(PG8_SB(1, 0), b3, voffB);
            PG8_BAR; PG8_WAIT_L(0); PG8_MMA(0, 1, At, B1); PG8_BAR;
            PG8_LDA(At, 1, 1); PG8_STAGE(PG8_SA(1, 0), a3, voffA);
            PG8_BAR; PG8_WAIT_L(0); PG8_MMA(1, 0, At, B0); PG8_BAR; PG8_SCHED;
            PG8_STAGE(PG8_SB(1, 1), b3 + hstep, voffB);
            PG8_WAIT_V(6); PG8_BAR; PG8_MMA(1, 1, At, B1); PG8_BAR;
            }
        }
        if constexpr (F8) asm volatile("s_nop 15\n\ts_nop 15" ::: "memory");
        if constexpr (ALIGN_EPI) { if (wr == 0) PG8_BAR; }
        if constexpr (!Epi::AFTER_DRAIN) { E(acc, cur, wr, wc, fr, fq); S.done(cur); }
        if (!has_next) break;
#pragma unroll
        for (int a = 0; a < 2; ++a)
#pragma unroll
            for (int b = 0; b < 2; ++b)
#pragma unroll
                for (int m = 0; m < 4; ++m)
#pragma unroll
                    for (int n = 0; n < 2; ++n) acc[a][b][m][n] = (f32x4){0.f, 0.f, 0.f, 0.f};
        cur = nxt; cA = nA; cB = nB; ++ui;
        if constexpr (ALIGN_EPI) { if (wr == 1) PG8_BAR; }
    }
    PG8_WAIT_V(0);
    if constexpr (!ALIGN_EPI) { if (wr == 0) PG8_BAR; }
    PG8_BAR;
    if constexpr (Epi::AFTER_DRAIN) { E.fused(acc, cur, wr, wc, fr, fq, lds, wid, lane); S.done(cur); }
#undef PG8_SA
#undef PG8_SB
#undef PG8_STAGE
#undef PG8_LDA
#undef PG8_LDB
#undef PG8_MMA
#undef PG8_WAIT_V
#undef PG8_WAIT_L
#undef PG8_BAR
#undef PG8_SCHED
}
}

namespace cg = cooperative_groups;
#define LAS __attribute__((address_space(3)))
typedef unsigned short bf16;
typedef unsigned v4u __attribute__((ext_vector_type(4)));
typedef unsigned v2u __attribute__((ext_vector_type(2)));
typedef float f32x4 __attribute__((ext_vector_type(4)));
typedef short bf16x8 __attribute__((ext_vector_type(8)));
typedef short s16x4 __attribute__((ext_vector_type(4)));

constexpr int NWAVES = 8;
constexpr int T = 12288, TP = 4096, D = 1024, FF = 2816, NGU = 5632, NQKV = 1536, NMOD = 9216;
constexpr float ALPHA = 1.4142135623730951f;
constexpr float LN_EPS = 1e-5f;
constexpr float LOG2E = 1.4426950408889634f;
constexpr int LDS_BYTES = 147456;
constexpr int N_PHASES = 22;

constexpr size_t MiB = 1u << 20;
constexpr size_t WS_MODV = 1 * MiB;
constexpr size_t WS_ROPE = 1 * MiB + 512 * 1024;
constexpr size_t WS_KC = 2 * MiB;
constexpr size_t WS_VCT = 2 * MiB + 512 * 1024;
constexpr size_t WS_PART = 4 * MiB;
constexpr size_t WS_WQKV = 8 * MiB, WS_WO = 11 * MiB, WS_WP = 13 * MiB;
constexpr size_t WS_WGU = 16 * MiB;
constexpr size_t WS_WD = 60 * MiB;
constexpr size_t WS_H = 82 * MiB;
constexpr size_t WS_A = 106 * MiB;
constexpr size_t WS_Q = 106 * MiB, WS_O = 130 * MiB;
constexpr size_t WS_KB = 172 * MiB;
constexpr size_t WS_VT = 178 * MiB;
constexpr size_t WS_END = 184 * MiB;

struct Args {
    const float* in[18];
    float* out;
    unsigned char* ws;
    int ph_lo, ph_hi;
};

#define LDS_WAIT() asm volatile("s_waitcnt lgkmcnt(0)" ::: "memory")
__device__ __forceinline__ unsigned pkbf(float lo, float hi) { return pg8::cvt_pk_bf16(lo, hi); }
__device__ __forceinline__ unsigned pk8(float a, float b, float c, float d) { int w = __builtin_amdgcn_cvt_pk_fp8_f32(a, b, 0, false); w = __builtin_amdgcn_cvt_pk_fp8_f32(c, d, w, true); return (unsigned)w; }
constexpr float WGU_SCALE = 64.f, WD_SCALE = 128.f;
__device__ __forceinline__ float wave_sum(float v) {
#pragma unroll
    for (int o = 1; o < 64; o <<= 1) v += __shfl_xor(v, o);
    return v;
}
__device__ __forceinline__ float silu_f(float x) { return x / (1.f + __expf(-x)); }

struct EpiSwiglu {
    static constexpr bool PERM = false, AFTER_DRAIN = false;
    unsigned char* A;
    __device__ __forceinline__ void operator()(const f32x4 (&acc)[2][2][4][2], const pg8::Unit& u, int wr, int wc, int fr, int fq) const {
        const int col = u.pn * 128 + wc * 32 + 8 * fq;
#pragma unroll
        for (int ai = 0; ai < 2; ++ai)
#pragma unroll
            for (int m = 0; m < 4; ++m) {
                const int row = u.pm * 256 + ai * 128 + wr * 64 + m * 16 + fr;
                float v[8];
#pragma unroll
                for (int n = 0; n < 2; ++n)
#pragma unroll
                    for (int e = 0; e < 4; ++e) { const float g = acc[ai][0][m][n][e] * (1.f / WGU_SCALE), up = acc[ai][1][m][n][e] * (1.f / WGU_SCALE); v[n * 4 + e] = g * __builtin_amdgcn_rcpf(1.f + __expf(-g)) * up; }
                v2u w; w.x = pk8(v[0], v[1], v[2], v[3]); w.y = pk8(v[4], v[5], v[6], v[7]);
                *(v2u*)(A + (size_t)row * FF + col) = w;
            }
    }
};
struct EpiResid {
    static constexpr bool PERM = false, AFTER_DRAIN = false;
    float* xy; const float* gate; const float* cscale; float mult;
    __device__ __forceinline__ void operator()(const f32x4 (&acc)[2][2][4][2], const pg8::Unit& u, int wr, int wc, int fr, int fq) const {
        const int cond = u.pm < 16 ? 0 : (u.pm < 32 ? 1 : 2);
        const float* g = gate + cond * NMOD;
#pragma unroll
        for (int bj = 0; bj < 2; ++bj)
#pragma unroll
            for (int n = 0; n < 2; ++n) {
                const int c = u.pn * 256 + bj * 128 + wc * 32 + n * 16 + 4 * fq;
                f32x4 gv = *(const f32x4*)(g + c) * mult;
                if (cscale) gv = gv * *(const f32x4*)(cscale + c);
#pragma unroll
                for (int ai = 0; ai < 2; ++ai)
#pragma unroll
                    for (int m = 0; m < 4; ++m) {
                        const int row = u.pm * 256 + ai * 128 + wr * 64 + m * 16 + fr;
                        float* p = xy + (size_t)row * D + c;
                        const f32x4 x = *(const f32x4*)p;
                        *(f32x4*)p = x * ALPHA + gv * acc[ai][bj][m][n];
                    }
            }
    }
};
struct EpiQKV {
    static constexpr bool PERM = false, AFTER_DRAIN = false;
    bf16* Q; bf16* Kb; bf16* Vt; float* sk; float* sv; const float* cosT; const float* sinT;
    __device__ __forceinline__ void operator()(const f32x4 (&acc)[2][2][4][2], const pg8::Unit& u, int wr, int wc, int fr, int fq) const {
        const int pn = u.pn;
#pragma unroll
        for (int ai = 0; ai < 2; ++ai)
#pragma unroll
            for (int m = 0; m < 4; ++m) {
                const int row = u.pm * 256 + ai * 128 + wr * 64 + m * 16 + fr;
                const bool latent = row >= TP;
                const int pos = (row - TP) & 4095;
                const int gpos = (wc & 1) ? (pos & 63) : (pos >> 6);
#pragma unroll
                for (int bj = 0; bj < 2; ++bj) {
                    f32x4 a0 = acc[ai][bj][m][0], a1 = acc[ai][bj][m][1];
                    const int cl = bj * 128 + wc * 32 + 4 * fq;
                    if (pn < 5 && latent) {
                        const f32x4 cs = *(const f32x4*)(cosT + gpos * 16 + 4 * fq), sn = *(const f32x4*)(sinT + gpos * 16 + 4 * fq);
                        const f32x4 r0 = a0 * cs - a1 * sn, r1 = a1 * cs + a0 * sn; a0 = r0; a1 = r1;
                    }
                    v2u w0, w1; w0.x = pkbf(a0[0], a0[1]); w0.y = pkbf(a0[2], a0[3]); w1.x = pkbf(a1[0], a1[1]); w1.y = pkbf(a1[2], a1[3]);
                    if (pn < 4) {
                        bf16* q = Q + (size_t)row * D + pn * 256 + cl;
                        *(v2u*)q = w0; *(v2u*)(q + 16) = w1;
                    } else if (pn == 4) {
                        bf16* k = Kb + (size_t)row * 256 + cl;
                        *(v2u*)k = w0; *(v2u*)(k + 16) = w1;
                        if (!latent) { float* s = sk + (size_t)row * 256 + cl; *(f32x4*)s = a0; *(f32x4*)(s + 16) = a1; }
                    } else {
                        bf16* v = Vt + (size_t)cl * T + row;
                        v[0] = (bf16)(w0.x & 0xffffu); v[(size_t)T] = (bf16)(w0.x >> 16); v[(size_t)2 * T] = (bf16)(w0.y & 0xffffu); v[(size_t)3 * T] = (bf16)(w0.y >> 16);
                        v += (size_t)16 * T;
                        v[0] = (bf16)(w1.x & 0xffffu); v[(size_t)T] = (bf16)(w1.x >> 16); v[(size_t)2 * T] = (bf16)(w1.y & 0xffffu); v[(size_t)3 * T] = (bf16)(w1.y >> 16);
                        if (!latent) { float* s = sv + (size_t)row * 256 + cl; *(f32x4*)s = a0; *(f32x4*)(s + 16) = a1; }
                    }
                }
            }
    }
};

__device__ __forceinline__ void tr_item(const float* W, int ldw, int k0, int n0, bf16* WT, int ldwt, int orow0, int ocol0, LAS float* scr, int lane) {
#pragma unroll 8
    for (int i = 0; i < 32; ++i) { const int kk = 2 * i + (lane >> 5); scr[kk * 33 + (lane & 31)] = W[(size_t)(k0 + kk) * ldw + n0 + (lane & 31)]; }
    LDS_WAIT(); asm volatile("" ::: "memory");
    const int c = lane & 7;
#pragma unroll
    for (int j = 0; j < 4; ++j) { const int n = (lane >> 3) + 8 * j; const LAS float* s = scr + (8 * c) * 33 + n;
        v4u o; o.x = pkbf(s[0 * 33], s[1 * 33]); o.y = pkbf(s[2 * 33], s[3 * 33]); o.z = pkbf(s[4 * 33], s[5 * 33]); o.w = pkbf(s[6 * 33], s[7 * 33]);
        *(v4u*)(WT + (size_t)(orow0 + n) * ldwt + ocol0 + k0 + 8 * c) = o; }
    LDS_WAIT(); asm volatile("" ::: "memory");
}
__device__ __forceinline__ void tr_item8(const float* W, int ldw, int k0, int n0, unsigned char* WT, int ldwt, int orow0, float scale, bool perm, LAS float* scr, int lane) {
#pragma unroll 8
    for (int i = 0; i < 32; ++i) { const int kk = 2 * i + (lane >> 5); scr[kk * 33 + (lane & 31)] = W[(size_t)(k0 + kk) * ldw + n0 + (lane & 31)] * scale; }
    LDS_WAIT(); asm volatile("" ::: "memory");
#pragma unroll
    for (int j = 0; j < 2; ++j) { const int q = lane + 64 * j, n = q >> 2, c = q & 3; const LAS float* p = scr + (16 * c) * 33 + n;
        v4u o; o.x = pk8(p[0 * 33], p[1 * 33], p[2 * 33], p[3 * 33]); o.y = pk8(p[4 * 33], p[5 * 33], p[6 * 33], p[7 * 33]);
        o.z = pk8(p[8 * 33], p[9 * 33], p[10 * 33], p[11 * 33]); o.w = pk8(p[12 * 33], p[13 * 33], p[14 * 33], p[15 * 33]);
        const int nr = perm ? (16 * ((n >> 2) & 1) + 4 * (n >> 3) + (n & 3)) : n;
        *(v4u*)(WT + (size_t)(orow0 + nr) * ldwt + k0 + 16 * c) = o; }
    LDS_WAIT(); asm volatile("" ::: "memory");
}
__device__ __forceinline__ void modv_item(const float* w_mod, const float* c, const float* c_ctx, float* part, int r, int lane) {
    const int l = r / 576, q = r % 576, nb = q / 16, kc = q % 16;
    const int k0 = kc * 64, n = nb * 256 + 4 * lane;
    const float s0 = silu_f(c_ctx[k0 + lane]), s1 = silu_f(c[k0 + lane]), s2 = silu_f(c[1024 + k0 + lane]);
    const float* W = w_mod + ((size_t)l * 1024 + k0) * NMOD + n;
    f32x4 a0 = {0.f, 0.f, 0.f, 0.f}, a1 = a0, a2 = a0;
#pragma unroll 16
    for (int kk = 0; kk < 64; ++kk) {
        const f32x4 w = __builtin_nontemporal_load((const f32x4*)(W + (size_t)kk * NMOD));
        const float t0 = __shfl(s0, kk), t1 = __shfl(s1, kk), t2 = __shfl(s2, kk);
        a0 += w * t0; a1 += w * t1; a2 += w * t2;
    }
    float* P = part + ((size_t)(kc * 2 + l) * 3) * NMOD + n;
    *(f32x4*)P = a0; *(f32x4*)(P + NMOD) = a1; *(f32x4*)(P + 2 * NMOD) = a2;
}

constexpr int I_MODV = 2 * 36 * 16, I_GU = 4 * 2 * 1408, I_DN = 4 * 1408, I_QKV = 16 * 48, I_WO = 16 * 32, I_POOL = 128, I_PZ = 1024, I_CV = 64, I_CK = 64, I_ROPE = 1;
constexpr int NITEMS = I_MODV + I_GU + I_DN + I_QKV + I_WO + I_POOL + I_PZ + I_CV + I_CK + I_ROPE;

__device__ __forceinline__ void p0a_phase(const Args& a, LAS unsigned char* ldsp, int gw, int NGW, int wave, int lane) {
    LAS float* scr = (LAS float*)(ldsp + wave * 16384);
    unsigned char* ws = a.ws;
    for (int it = gw; it < NITEMS; it += NGW) {
        int r = it;
        if (r < I_MODV) { modv_item(a.in[6], a.in[4], a.in[5], (float*)(ws + WS_PART), r, lane); continue; } r -= I_MODV;
        if (r < I_GU) { const int lj = r / 2816, rr = r % 2816, up = rr / 1408, q = rr % 1408, kb = q / 88, nb = q % 88, n0 = 32 * nb;
            tr_item8((up ? a.in[11] : a.in[10]) + (size_t)lj * D * FF, FF, 64 * kb, n0, ws + WS_WGU + (size_t)lj * NGU * D, D, 256 * (n0 / 128) + (n0 % 128) + (up ? 128 : 0), WGU_SCALE, true, scr, lane); continue; } r -= I_GU;
        if (r < I_DN) { const int lj = r / 1408, q = r % 1408, kb = q / 32, nb = q % 32;
            tr_item8(a.in[12] + (size_t)lj * FF * D, D, 64 * kb, 32 * nb, ws + WS_WD + (size_t)lj * D * FF, FF, 32 * nb, WD_SCALE, false, scr, lane); continue; } r -= I_DN;
        if (r < I_QKV) { const int kb = r / 48, nb = r % 48; tr_item(a.in[13], NQKV, 64 * kb, 32 * nb, (bf16*)(ws + WS_WQKV), D, 32 * nb, 0, scr, lane); continue; } r -= I_QKV;
        if (r < I_WO) { const int kb = r / 32, nb = r % 32; tr_item(a.in[14], D, 64 * kb, 32 * nb, (bf16*)(ws + WS_WO), D, 32 * nb, 0, scr, lane); continue; } r -= I_WO;
        if (r < I_POOL) { const int g = r / 32, rr = r % 32, kb = rr / 8, nb = rr % 8;
            tr_item(a.in[16] + (size_t)g * 65536, 256, 64 * kb, 32 * nb, (bf16*)(ws + WS_WP), D, 256 * g + 32 * nb, 256 * g, scr, lane); continue; } r -= I_POOL;
        if (r < I_PZ) { bf16* row = (bf16*)(ws + WS_WP) + (size_t)r * D; const int g = r >> 8;
#pragma unroll
            for (int i = 0; i < 2; ++i) { const int ch = lane + 64 * i; if (((8 * ch) >> 8) != g) *(v4u*)(row + 8 * ch) = (v4u){0u, 0u, 0u, 0u}; }
            continue; } r -= I_PZ;
        if (r < I_CV) { const int b = r / 32, rr = r % 32, kb = rr / 8, nb = rr % 8;
            tr_item(a.in[3] + (size_t)b * 65536, 256, 64 * kb, 32 * nb, (bf16*)(ws + WS_VCT) + (size_t)b * 65536, 256, 32 * nb, 0, scr, lane); continue; } r -= I_CV;
        if (r < I_CK) { const float* src = a.in[2] + (size_t)r * 2048; bf16* dst = (bf16*)(ws + WS_KC) + (size_t)r * 2048;
#pragma unroll
            for (int i = 0; i < 4; ++i) { const int idx = i * 512 + lane * 8; const f32x4 x = *(const f32x4*)(src + idx), y = *(const f32x4*)(src + idx + 4);
                v4u o; o.x = pkbf(x[0], x[1]); o.y = pkbf(x[2], x[3]); o.z = pkbf(y[0], y[1]); o.w = pkbf(y[2], y[3]); *(v4u*)(dst + idx) = o; }
            continue; } r -= I_CK;
        { float* cosT = (float*)(ws + WS_ROPE); float* sinT = cosT + 1024;
#pragma unroll 1
            for (int f = 0; f < 16; ++f) { const float inv = exp2f(-(float)f * (13.287712379549449f / 16.f)); const float ang = (float)lane * inv;
                cosT[lane * 16 + f] = cosf(ang); sinT[lane * 16 + f] = sinf(ang); } }
    }
}
__device__ __forceinline__ void p0b_phase(const Args& a, int gtid, int NT) {
    const float* part = (const float*)(a.ws + WS_PART); float* modv = (float*)(a.ws + WS_MODV); const float* b_mod = a.in[7];
    for (int i = gtid; i < 2 * 3 * (NMOD / 4); i += NT) {
        const int l = i / 6912, rem = i % 6912, cond = rem / 2304, n = 4 * (rem % 2304);
        f32x4 s = *(const f32x4*)(b_mod + l * NMOD + n);
#pragma unroll
        for (int kc = 0; kc < 16; ++kc) s += *(const f32x4*)(part + ((size_t)(kc * 2 + l) * 3 + cond) * NMOD + n);
        *(f32x4*)(modv + (size_t)(l * 3 + cond) * NMOD + n) = s;
    }
}

__device__ __forceinline__ void ln_phase(int mode, int f8, const float* xin_p, const float* xin_s, float* xy, bf16* H, const float* g, const float* b,
                                         const float* modl, int ishift, int iscale, int gw, int NGW, int lane) {
    for (int r = gw; r < T; r += NGW) {
        const int cond = r < TP ? 0 : (r < 2 * TP ? 1 : 2);
        const float* src = (mode == 0) ? (r < TP ? xin_p + (size_t)r * D : xin_s + (size_t)(r - TP) * D) : xy + (size_t)r * D;
        f32x4 v[4];
#pragma unroll
        for (int j = 0; j < 4; ++j) v[j] = *(const f32x4*)(src + 256 * j + 4 * lane);
        if (mode != 0) {
            float s = 0.f;
#pragma unroll
            for (int j = 0; j < 4; ++j) s += (v[j][0] + v[j][1]) + (v[j][2] + v[j][3]);
            const float mean = wave_sum(s) * (1.f / D); float s2 = 0.f;
#pragma unroll
            for (int j = 0; j < 4; ++j) { v[j] = v[j] - mean; s2 += (v[j][0] * v[j][0] + v[j][1] * v[j][1]) + (v[j][2] * v[j][2] + v[j][3] * v[j][3]); }
            const float rstd = 1.f / sqrtf(wave_sum(s2) * (1.f / D) + LN_EPS);
#pragma unroll
            for (int j = 0; j < 4; ++j) v[j] = v[j] * rstd * *(const f32x4*)(g + 256 * j + 4 * lane) + *(const f32x4*)(b + 256 * j + 4 * lane);
        }
#pragma unroll
        for (int j = 0; j < 4; ++j) *(f32x4*)(xy + (size_t)r * D + 256 * j + 4 * lane) = v[j];
        if (mode != 2) {
            const float* sh = modl + cond * NMOD + ishift * D; const float* sc = modl + cond * NMOD + iscale * D;
#pragma unroll
            for (int j = 0; j < 4; ++j) { const f32x4 h = v[j] * (*(const f32x4*)(sc + 256 * j + 4 * lane) + 1.f) + *(const f32x4*)(sh + 256 * j + 4 * lane);
                if (f8) { *(unsigned*)((unsigned char*)H + (size_t)r * D + 256 * j + 4 * lane) = pk8(h[0], h[1], h[2], h[3]); }
                else { v2u w; w.x = pkbf(h[0], h[1]); w.y = pkbf(h[2], h[3]); *(v2u*)(H + (size_t)r * D + 256 * j + 4 * lane) = w; } }
        }
    }
}
__device__ __forceinline__ void pool_phase(const float* xy, bf16* P, const float* modl, int iscale, int gw, int NGW, int lane) {
    for (int r = gw; r < T; r += NGW) {
        const int cond = r < TP ? 0 : (r < 2 * TP ? 1 : 2);
        const int s0 = r < TP ? (r & ~255) : (TP + ((r - TP) & ~4095)), L = r < TP ? 256 : 4096, pos = r - s0;
        const float* sc = modl + cond * NMOD + iscale * D;
#pragma unroll
        for (int j = 0; j < 4; ++j) {
            const int hw = 1 << j, lo = max(pos - hw, 0), hi = min(pos + hw, L);
            f32x4 sum = {0.f, 0.f, 0.f, 0.f};
            for (int jj = lo; jj < hi; ++jj) sum += *(const f32x4*)(xy + (size_t)(s0 + jj) * D + 256 * j + 4 * lane);
            const f32x4 ctr = *(const f32x4*)(xy + (size_t)r * D + 256 * j + 4 * lane);
            const float cnt = (float)(hi - lo);
            f32x4 pl; pl[0] = sum[0] / cnt - ctr[0]; pl[1] = sum[1] / cnt - ctr[1]; pl[2] = sum[2] / cnt - ctr[2]; pl[3] = sum[3] / cnt - ctr[3];
            pl = pl * (*(const f32x4*)(sc + 256 * j + 4 * lane) + 1.f);
            v2u w; w.x = pkbf(pl[0], pl[1]); w.y = pkbf(pl[2], pl[3]); *(v2u*)(P + (size_t)r * D + 256 * j + 4 * lane) = w;
        }
    }
}

struct AttnState { float m[4], l[4]; f32x4 o[4][4]; };
template <bool MASK>
__device__ __forceinline__ void attn_tiles(AttnState& st, const bf16x8 (&qf)[4][2], const bf16* Kp, const bf16* Vp, int ldv, int kbeg, int kend, int qpos, int fr, int fq) {
    constexpr float SC = 0.125f * LOG2E;
    for (int ks = kbeg; ks < kend; ks += 32) {
        bf16x8 kf[2][2]; bf16x8 vf[4];
#pragma unroll
        for (int s = 0; s < 2; ++s)
#pragma unroll
            for (int dc = 0; dc < 2; ++dc) kf[s][dc] = *(const bf16x8*)(Kp + (size_t)(ks + 16 * s + fr) * 256 + dc * 32 + fq * 8);
#pragma unroll
        for (int dd = 0; dd < 4; ++dd) { const bf16* vp = Vp + (size_t)(16 * dd + fr) * ldv + ks + 4 * fq; const s16x4 lo = *(const s16x4*)vp, hi = *(const s16x4*)(vp + 16);
            vf[dd] = (bf16x8){lo[0], lo[1], lo[2], lo[3], hi[0], hi[1], hi[2], hi[3]}; }
#pragma unroll
        for (int hh = 0; hh < 4; ++hh) {
            f32x4 s0 = {0.f, 0.f, 0.f, 0.f}, s1 = s0;
            s0 = __builtin_amdgcn_mfma_f32_16x16x32_bf16(kf[0][0], qf[hh][0], s0, 0, 0, 0); s0 = __builtin_amdgcn_mfma_f32_16x16x32_bf16(kf[0][1], qf[hh][1], s0, 0, 0, 0);
            s1 = __builtin_amdgcn_mfma_f32_16x16x32_bf16(kf[1][0], qf[hh][0], s1, 0, 0, 0); s1 = __builtin_amdgcn_mfma_f32_16x16x32_bf16(kf[1][1], qf[hh][1], s1, 0, 0, 0);
            s0 = s0 * SC; s1 = s1 * SC;
            if (MASK) {
#pragma unroll
                for (int e = 0; e < 4; ++e) { const int k0 = ks + 4 * fq + e, d0 = qpos - k0, d1 = d0 - 16;
                    if (d0 > 128 || d0 < -128) s0[e] = -1e30f; if (d1 > 128 || d1 < -128) s1[e] = -1e30f; }
            }
            float rm = fmaxf(fmaxf(fmaxf(s0[0], s0[1]), fmaxf(s0[2], s0[3])), fmaxf(fmaxf(s1[0], s1[1]), fmaxf(s1[2], s1[3])));
            rm = fmaxf(rm, __shfl_xor(rm, 16)); rm = fmaxf(rm, __shfl_xor(rm, 32));
            const float mn = fmaxf(st.m[hh], rm), f = __builtin_amdgcn_exp2f(st.m[hh] - mn); st.m[hh] = mn;
            float p[8];
#pragma unroll
            for (int e = 0; e < 4; ++e) { p[e] = __builtin_amdgcn_exp2f(s0[e] - mn); p[4 + e] = __builtin_amdgcn_exp2f(s1[e] - mn); }
            st.l[hh] = st.l[hh] * f + ((p[0] + p[1]) + (p[2] + p[3])) + ((p[4] + p[5]) + (p[6] + p[7]));
            v4u pw; pw.x = pkbf(p[0], p[1]); pw.y = pkbf(p[2], p[3]); pw.z = pkbf(p[4], p[5]); pw.w = pkbf(p[6], p[7]);
            const bf16x8 pf = __builtin_bit_cast(bf16x8, pw);
#pragma unroll
            for (int dd = 0; dd < 4; ++dd) { st.o[hh][dd] = st.o[hh][dd] * f; st.o[hh][dd] = __builtin_amdgcn_mfma_f32_16x16x32_bf16(vf[dd], pf, st.o[hh][dd], 0, 0, 0); }
        }
    }
}
__device__ __forceinline__ void attn_phase(const bf16* Q, const bf16* Kb, const bf16* Vt, const bf16* Kc, const bf16* Vct, bf16* O, const float* sink, int gw, int NGW, int lane) {
    const int fr = lane & 15, fq = lane >> 4;
    for (int item = gw; item < 3072; item += NGW) {
        int seqbase, kvh, t0, b; const bool latent = item < 2048;
        if (latent) { b = item >> 10; kvh = (item >> 8) & 3; t0 = (item & 255) * 16; seqbase = TP + b * 4096; }
        else { const int it = item - 2048; b = it >> 6; kvh = (it >> 4) & 3; t0 = (it & 15) * 16; seqbase = b * 256; }
        bf16x8 qf[4][2];
#pragma unroll
        for (int hh = 0; hh < 4; ++hh)
#pragma unroll
            for (int dc = 0; dc < 2; ++dc) qf[hh][dc] = *(const bf16x8*)(Q + (size_t)(seqbase + t0 + fr) * D + (kvh * 4 + hh) * 64 + dc * 32 + fq * 8);
        AttnState st;
#pragma unroll
        for (int hh = 0; hh < 4; ++hh) { st.m[hh] = sink[kvh * 4 + hh] * LOG2E; st.l[hh] = (fq == 0) ? 1.f : 0.f;
#pragma unroll
            for (int dd = 0; dd < 4; ++dd) st.o[hh][dd] = (f32x4){0.f, 0.f, 0.f, 0.f}; }
        const bf16* Kp = Kb + (size_t)seqbase * 256 + kvh * 64; const bf16* Vp = Vt + (size_t)(kvh * 64) * T + seqbase;
        if (latent) {
            const int kb = max(0, t0 - 128) & ~31, ke = min(4096, t0 + 144);
            attn_tiles<true>(st, qf, Kp, Vp, T, kb, ke, t0 + fr, fr, fq);
            attn_tiles<false>(st, qf, Kc + (size_t)b * 65536 + kvh * 64, Vct + (size_t)b * 65536 + (size_t)(kvh * 64) * 256, 256, 0, 256, 0, fr, fq);
        } else {
            attn_tiles<false>(st, qf, Kp, Vp, T, 0, 256, 0, fr, fq);
        }
#pragma unroll
        for (int hh = 0; hh < 4; ++hh) {
            float l = st.l[hh]; l += __shfl_xor(l, 16); l += __shfl_xor(l, 32);
            const float inv = 1.f / l;
            bf16* op = O + (size_t)(seqbase + t0 + fr) * D + (kvh * 4 + hh) * 64 + 4 * fq;
#pragma unroll
            for (int dd = 0; dd < 4; ++dd) { const f32x4 o = st.o[hh][dd] * inv; v2u w; w.x = pkbf(o[0], o[1]); w.y = pkbf(o[2], o[3]); *(v2u*)(op + 16 * dd) = w; }
        }
    }
}

enum { K_P0A = 0, K_P0B, K_LN, K_UP, K_RES, K_QKV, K_ATT, K_POOL };

__global__ void __launch_bounds__(NWAVES * 64, 2) mk_fwd(Args args) {
    extern __shared__ __attribute__((aligned(16))) unsigned char lds[];
    LAS unsigned char* ldsp = (LAS unsigned char*)lds;
    const int tid = threadIdx.x, lane = tid & 63, wave = __builtin_amdgcn_readfirstlane(tid >> 6);
    const int G = gridDim.x, gw = blockIdx.x * NWAVES + wave, NGW = G * NWAVES;
    unsigned char* ws = args.ws;
    float* xy = args.out;
    float* sk = args.out + (size_t)T * D; float* sv = sk + (size_t)TP * 256;
    float* modv = (float*)(ws + WS_MODV);
    bf16* H = (bf16*)(ws + WS_H); bf16* A = (bf16*)(ws + WS_A); bf16* Qb = (bf16*)(ws + WS_Q); bf16* Ob = (bf16*)(ws + WS_O);
    bf16* Kb = (bf16*)(ws + WS_KB); bf16* Vt = (bf16*)(ws + WS_VT);

    const int lo = args.ph_lo, hi = args.ph_hi;
#define IN(k) (lo <= (k) && (k) < hi)
#define SEAM(k) do { if ((k) + 1 < hi) cg::this_grid().sync(); } while (0)
#define MODL(l) (modv + (size_t)(l) * 3 * NMOD)
#define PH_LN(k, mode, f8, lnidx, l, mi) if (IN(k)) { ln_phase(mode, f8, args.in[0], args.in[1], xy, H, args.in[8] + (lnidx) * D, args.in[9] + (lnidx) * D, MODL(l), mi, (mi) + 1, gw, NGW, lane); SEAM(k); }
#define PH_UP(k, lj) if (IN(k)) { pg8::Gemm g{H, (const bf16*)(ws + WS_WGU + (size_t)(lj) * NGU * D), T, NGU, D / 2}; pg8::StaticOrder S; S.init(T, NGU, G, (int)blockIdx.x); \
        EpiSwiglu E{(unsigned char*)A}; pg8::gemm_phase<EpiSwiglu, pg8::StaticOrder, true, true, true>(ldsp, g, S, E); SEAM(k); }
#define PH_DOWN(k, lj, l, gi) if (IN(k)) { pg8::Gemm g{A, (const bf16*)(ws + WS_WD + (size_t)(lj) * D * FF), T, D, FF / 2}; pg8::StaticOrder S; S.init(T, D, G, (int)blockIdx.x); \
        EpiResid E{xy, MODL(l) + (gi) * D, nullptr, 0.5f / WD_SCALE}; pg8::gemm_phase<EpiResid, pg8::StaticOrder, true, true, true>(ldsp, g, S, E); SEAM(k); }
#define PH_RESD(k, Ap, Wp, l, gi, cs) if (IN(k)) { pg8::Gemm g{Ap, (const bf16*)(ws + (Wp)), T, D, D}; pg8::StaticOrder S; S.init(T, D, G, (int)blockIdx.x); \
        EpiResid E{xy, MODL(l) + (gi) * D, cs, 1.0f}; pg8::gemm_phase<EpiResid, pg8::StaticOrder, true, true>(ldsp, g, S, E); SEAM(k); }

    if (IN(0)) { p0a_phase(args, ldsp, gw, NGW, wave, lane); SEAM(0); }
    if (IN(1)) { p0b_phase(args, blockIdx.x * (NWAVES * 64) + tid, G * NWAVES * 64); SEAM(1); }
    PH_LN(2, 0, 1, 0, 0, 0)
    PH_UP(3, 0)
    PH_DOWN(4, 0, 0, 2)
    PH_LN(5, 1, 0, 0, 0, 3)
    if (IN(6)) { pg8::Gemm g{H, (const bf16*)(ws + WS_WQKV), T, NQKV, D}; pg8::StaticOrder S; S.init(T, NQKV, G, (int)blockIdx.x);
        EpiQKV E{Qb, Kb, Vt, sk, sv, (const float*)(ws + WS_ROPE), (const float*)(ws + WS_ROPE) + 1024};
        pg8::gemm_phase<EpiQKV, pg8::StaticOrder, true, true>(ldsp, g, S, E); SEAM(6); }
    if (IN(7)) { attn_phase(Qb, Kb, Vt, (const bf16*)(ws + WS_KC), (const bf16*)(ws + WS_VCT), Ob, args.in[15], gw, NGW, lane); SEAM(7); }
    PH_RESD(8, Ob, WS_WO, 0, 5, nullptr)
    PH_LN(9, 1, 1, 1, 0, 6)
    PH_UP(10, 1)
    PH_DOWN(11, 1, 0, 8)
    PH_LN(12, 1, 1, 2, 1, 0)
    PH_UP(13, 2)
    PH_DOWN(14, 2, 1, 2)
    PH_LN(15, 2, 0, 3, 1, 0)
    if (IN(16)) { pool_phase(xy, H, MODL(1), 4, gw, NGW, lane); SEAM(16); }
    PH_RESD(17, H, WS_WP, 1, 5, args.in[17])
    PH_LN(18, 1, 1, 4, 1, 6)
    PH_UP(19, 3)
    PH_DOWN(20, 3, 1, 8)
    PH_LN(21, 2, 0, 5, 1, 0)
#undef IN
#undef SEAM
}

extern "C" void kernel_launch(void* const* d_in, const int* in_sizes, int n_in, void* d_out, int out_size, void* d_ws, size_t ws_size, hipStream_t stream) {
    static int grid = 0;
    if (grid == 0) {
        if (n_in != 18 || ws_size < WS_END) { fprintf(stderr, "kernel_launch: unexpected inputs (n_in %d, ws %zu)\n", n_in, ws_size); grid = -1; return; }
        int dev = 0, cus = 0, per_cu = 0;
        hipGetDevice(&dev); hipDeviceGetAttribute(&cus, hipDeviceAttributeMultiprocessorCount, dev);
        if (hipFuncSetAttribute((const void*)mk_fwd, hipFuncAttributeMaxDynamicSharedMemorySize, LDS_BYTES) != hipSuccess) { fprintf(stderr, "kernel_launch: hipFuncSetAttribute failed\n"); grid = -1; return; }
        if (hipOccupancyMaxActiveBlocksPerMultiprocessor(&per_cu, (const void*)mk_fwd, NWAVES * 64, LDS_BYTES) != hipSuccess || per_cu < 1) { fprintf(stderr, "kernel_launch: occupancy query says %d\n", per_cu); per_cu = 1; }
        (void)hipGetLastError();
        grid = cus * 1;
        if (grid <= 0) grid = 256;
    }
    if (grid < 0) return;
    Args a{};
    for (int i = 0; i < 18; ++i) a.in[i] = (const float*)d_in[i];
    a.out = (float*)d_out; a.ws = (unsigned char*)d_ws;
#if MK_PER_PHASE
    for (int ph = 0; ph < N_PHASES; ++ph) { a.ph_lo = ph; a.ph_hi = ph + 1; hipLaunchKernelGGL(mk_fwd, dim3(grid), dim3(NWAVES * 64), LDS_BYTES, stream, a); }
#else
    a.ph_lo = 0; a.ph_hi = N_PHASES;
    void* kargs[] = {&a};
    hipError_t e = hipLaunchCooperativeKernel((const void*)mk_fwd, dim3(grid), dim3(NWAVES * 64), kargs, LDS_BYTES, stream);
    if (e != hipSuccess) fprintf(stderr, "kernel_launch: cooperative launch failed: %s (grid %d)\n", hipGetErrorString(e), grid);
#endif
}
```

```cpp
#include <hip/hip_runtime.h>
#include <hip/hip_cooperative_groups.h>
#include <cstdio>
#include <cstdint>
#ifndef MK_PER_PHASE
#define MK_PER_PHASE 0
#endif
#ifndef PROBE
#define PROBE 0
#endif
namespace pg8 {
#define PG8_LAS __attribute__((address_space(3)))
typedef unsigned short bf16_t;
typedef short bf16x8 __attribute__((ext_vector_type(8)));
typedef float f32x4 __attribute__((ext_vector_type(4)));
typedef unsigned u32x4 __attribute__((ext_vector_type(4)));
constexpr int BM = 256, BK = 64, HALF = 128, HTB = HALF * BK * 2  , STAGE_BYTES = 8 * HTB, NXCD = 8, WGM = 8;

__host__ __device__ __forceinline__ int lds_byte(int r, int c) { const int st = (r >> 4) * 2 + (c >> 5), rr = r & 15, cc = c & 31, ob = rr * 64 + cc * 2; return st * 1024 + (ob ^ (((ob >> 9) & 1) << 5)); }
__host__ __device__ __forceinline__ void stage_rc(int b, int& R, int& C) { const int st = b / 1024, sb = b % 1024, swz = sb ^ (((sb >> 9) & 1) << 5); R = (st >> 1) * 16 + swz / 64; C = (st & 1) * 32 + (swz % 64) / 2; }
__host__ __device__ __forceinline__ int perm32(int rho) { const int n = rho >> 4, i = rho & 15; return 8 * (i >> 2) + 4 * n + (i & 3); }

struct Unit { int pm, pn; };
struct Gemm { const bf16_t* A; const bf16_t* Bt; int M, N, K; };

struct StaticOrder {
    int nM, nN, nwg, G, c;
    __host__ __device__ void init(int M, int N, int G_, int c_) { nM = M / BM; nN = N / BM; nwg = nM * nN; G = G_; c = c_; }
    __host__ __device__ bool next(int i, Unit& u) const {
        const long L = (long)i * G + c; if (L >= nwg) return false;
        int wgid = (int)L; { const int q = nwg / NXCD, r = nwg % NXCD, xcd = wgid % NXCD, off = wgid / NXCD; wgid = (xcd < r ? xcd * (q + 1) : r * (q + 1) + (xcd - r) * q) + off; }
        const int nig = WGM * nN, gid = wgid / nig, fm = gid * WGM, gsz = (nM - fm) < WGM ? (nM - fm) : WGM;
        u.pm = fm + ((wgid % nig) % gsz); u.pn = (wgid % nig) / gsz; return true;
    }
    __device__ __forceinline__ void a_ready(const Unit&) const {}
    __device__ __forceinline__ void done(const Unit&) const {}
};

__device__ __forceinline__ unsigned cvt_pk_bf16(float lo, float hi) { unsigned r; asm volatile("v_cvt_pk_bf16_f32 %0, %1, %2" : "=v"(r) : "v"(lo), "v"(hi)); return r; }
__device__ __forceinline__ void mfma8(f32x4& c, bf16x8 a0, bf16x8 a1, bf16x8 b0, bf16x8 b1) {
    typedef int i32x4 __attribute__((ext_vector_type(4))); typedef int i32x8 __attribute__((ext_vector_type(8)));
    const i32x8 a = __builtin_shufflevector(__builtin_bit_cast(i32x4, a0), __builtin_bit_cast(i32x4, a1), 0, 1, 2, 3, 4, 5, 6, 7);
    const i32x8 b = __builtin_shufflevector(__builtin_bit_cast(i32x4, b0), __builtin_bit_cast(i32x4, b1), 0, 1, 2, 3, 4, 5, 6, 7);
    asm volatile("v_mfma_f32_16x16x128_f8f6f4 %0, %1, %2, %0" : "+v"(c) : "v"(a), "v"(b));
}
template <class Epi, class Sched, bool ALIGN_EPI = false, bool SP2 = false, bool F8 = false>
__device__ __forceinline__ void gemm_phase(PG8_LAS unsigned char* lds, const Gemm g, const Sched& S, const Epi& E) {
    const int tid = threadIdx.x, wid = __builtin_amdgcn_readfirstlane(tid >> 6), lane = tid & 63, wr = wid >> 2, wc = wid & 3, fr = lane & 15, fq = lane >> 4;
    const int K = g.K, nt = K / BK;
    unsigned voffA[2], voffB[2];
#pragma unroll
    for (int i = 0; i < 2; ++i) { int R, C; stage_rc(tid * 16 + i * 8192, R, C); const int Rb = Epi::PERM ? ((R & ~31) + perm32(R & 31)) : R;
        voffA[i] = (unsigned)(R * K + C) * 2u; voffB[i] = (unsigned)(Rb * K + C) * 2u; }
    const size_t kstep = (size_t)(BK * 2);
    const size_t hstep = (size_t)HALF * K * 2;
    const size_t tstep = 2 * hstep;
    const unsigned ldsw = (unsigned)wid * 1024u;
    const int aoff = lds_byte(wr * 64 + fr, fq * 8), boff = lds_byte(wc * 32 + fr, fq * 8);
#define PG8_SA(b, h) (((b) * 2 + (h)) * HTB)
#define PG8_SB(b, h) ((4 + (b) * 2 + (h)) * HTB)
#define PG8_STAGE(bufoff, gbase, voff) do { _Pragma("unroll") for (int _i = 0; _i < 2; ++_i) \
        __builtin_amdgcn_global_load_lds((const unsigned*)((const char*)(gbase) + (voff)[_i]), (PG8_LAS unsigned*)(lds + (bufoff) + ldsw + _i * 8192), 16, 0, 0); } while (0)
#define PG8_LDA(dst, b, h) do { _Pragma("unroll") for (int m = 0; m < 4; ++m) _Pragma("unroll") for (int k = 0; k < 2; ++k) dst[m][k] = *(const PG8_LAS bf16x8*)(lds + PG8_SA(b, h) + aoff + m * 2048 + k * 1024); } while (0)
#define PG8_LDB(dst, b, h) do { _Pragma("unroll") for (int n = 0; n < 2; ++n) _Pragma("unroll") for (int k = 0; k < 2; ++k) dst[n][k] = *(const PG8_LAS bf16x8*)(lds + PG8_SB(b, h) + boff + n * 2048 + k * 1024); } while (0)
#define PG8_MMA(ai, bj, At, Bt) do { __builtin_amdgcn_s_setprio(1); _Pragma("unroll") for (int m = 0; m < 4; ++m) _Pragma("unroll") for (int n = 0; n < 2; ++n) { \
        if constexpr (F8) { mfma8(acc[ai][bj][m][n], Bt[n][0], Bt[n][1], At[m][0], At[m][1]); } \
        else { _Pragma("unroll") for (int k = 0; k < 2; ++k) acc[ai][bj][m][n] = __builtin_amdgcn_mfma_f32_16x16x32_bf16(Bt[n][k], At[m][k], acc[ai][bj][m][n], 0, 0, 0); } } \
        __builtin_amdgcn_s_setprio(0); } while (0)
#define PG8_WAIT_V(n) asm volatile("s_waitcnt vmcnt(" #n ")" ::: "memory")
#define PG8_WAIT_L(n) asm volatile("s_waitcnt lgkmcnt(" #n ")" ::: "memory")
#define PG8_BAR __builtin_amdgcn_s_barrier()
#define PG8_SCHED __builtin_amdgcn_sched_barrier(0)
    Unit cur, nxt; int ui = 0;
    if (!S.next(0, cur)) return;
    f32x4 acc[2][2][4][2];
#pragma unroll
    for (int a = 0; a < 2; ++a)
#pragma unroll
        for (int b = 0; b < 2; ++b)
#pragma unroll
            for (int m = 0; m < 4; ++m)
#pragma unroll
                for (int n = 0; n < 2; ++n) acc[a][b][m][n] = (f32x4){0.f, 0.f, 0.f, 0.f};
    bf16x8 At[4][2], B0[2][2], B1[2][2];
    const char* cA = (const char*)g.A + (size_t)cur.pm * tstep; const char* cB = (const char*)g.Bt + (size_t)cur.pn * tstep;
    S.a_ready(cur);
    if constexpr (SP2) {
        PG8_STAGE(PG8_SB(0, 0), cB, voffB); PG8_STAGE(PG8_SB(0, 1), cB + hstep, voffB); PG8_STAGE(PG8_SA(0, 0), cA, voffA); PG8_STAGE(PG8_SA(0, 1), cA + hstep, voffA);
        if (wr == 1) PG8_BAR;
        PG8_WAIT_V(2); PG8_BAR;
        PG8_STAGE(PG8_SB(1, 0), cB + kstep, voffB); PG8_STAGE(PG8_SA(1, 0), cA + kstep, voffA); PG8_STAGE(PG8_SB(1, 1), cB + hstep + kstep, voffB);
        PG8_WAIT_V(6); PG8_BAR;
    } else {
        PG8_STAGE(PG8_SB(0, 0), cB, voffB); PG8_STAGE(PG8_SA(0, 0), cA, voffA); PG8_STAGE(PG8_SB(0, 1), cB + hstep, voffB); PG8_STAGE(PG8_SA(0, 1), cA + hstep, voffA);
        if (wr == 1) PG8_BAR;
        PG8_WAIT_V(4); PG8_BAR;
        PG8_STAGE(PG8_SB(1, 0), cB + kstep, voffB); PG8_STAGE(PG8_SA(1, 0), cA + kstep, voffA); PG8_STAGE(PG8_SB(1, 1), cB + hstep + kstep, voffB);
        PG8_WAIT_V(6); PG8_BAR;
    }
    for (;;) {
        const bool has_next = S.next(ui + 1, nxt);
        const char* nA = has_next ? (const char*)g.A + (size_t)nxt.pm * tstep : cA; const char* nB = has_next ? (const char*)g.Bt + (size_t)nxt.pn * tstep : cB;
        for (int t = 0; t < nt; t += 2) {
            const bool last = (t == nt - 2);
            const char* a1 = cA + (size_t)(t + 1) * kstep;
            const char* a2 = last ? nA : cA + (size_t)(t + 2) * kstep; const char* b2 = last ? nB : cB + (size_t)(t + 2) * kstep;
            const char* a3 = a2 + kstep; const char* b3 = b2 + kstep;
            if (last && has_next) S.a_ready(nxt);
            if constexpr (SP2) {
            PG8_LDB(B0, 0, 0); PG8_LDB(B1, 0, 1); PG8_SCHED; PG8_LDA(At, 0, 0); PG8_STAGE(PG8_SA(1, 1), a1 + hstep, voffA);
            PG8_WAIT_V(8); PG8_WAIT_L(0); PG8_BAR; PG8_MMA(0, 0, At, B0); PG8_MMA(0, 1, At, B1); PG8_BAR; PG8_SCHED;
            PG8_LDA(At, 0, 1); PG8_STAGE(PG8_SB(0, 0), b2, voffB); PG8_STAGE(PG8_SB(0, 1), b2 + hstep, voffB); PG8_STAGE(PG8_SA(0, 0), a2, voffA);
            PG8_WAIT_V(8); PG8_WAIT_L(0); PG8_BAR; PG8_MMA(1, 0, At, B0); PG8_MMA(1, 1, At, B1); PG8_BAR; PG8_SCHED;
            PG8_LDB(B0, 1, 0); PG8_LDB(B1, 1, 1); PG8_SCHED; PG8_LDA(At, 1, 0); PG8_STAGE(PG8_SA(0, 1), a2 + hstep, voffA);
            PG8_WAIT_V(8); PG8_WAIT_L(0); PG8_BAR; PG8_MMA(0, 0, At, B0); PG8_MMA(0, 1, At, B1); PG8_BAR; PG8_SCHED;
            PG8_LDA(At, 1, 1); PG8_STAGE(PG8_SB(1, 0), b3, voffB); PG8_STAGE(PG8_SB(1, 1), b3 + hstep, voffB); PG8_STAGE(PG8_SA(1, 0), a3, voffA);
            PG8_WAIT_V(8); PG8_WAIT_L(0); PG8_BAR; PG8_MMA(1, 0, At, B0); PG8_MMA(1, 1, At, B1); PG8_BAR; PG8_SCHED;
            } else {
            PG8_LDB(B0, 0, 0); PG8_SCHED; PG8_LDA(At, 0, 0); PG8_STAGE(PG8_SA(1, 1), a1 + hstep, voffA);
            PG8_WAIT_L(8); PG8_BAR; PG8_WAIT_L(0); PG8_MMA(0, 0, At, B0); PG8_BAR; PG8_SCHED;
            PG8_LDB(B1, 0, 1); PG8_STAGE(PG8_SB(0, 0), b2, voffB);
            PG8_BAR; PG8_WAIT_L(0); PG8_MMA(0, 1, At, B1); PG8_BAR;
            PG8_LDA(At, 0, 1); PG8_STAGE(PG8_SA(0, 0), a2, voffA);
            PG8_BAR; PG8_WAIT_L(0); PG8_MMA(1, 0, At, B0); PG8_BAR; PG8_SCHED;
            PG8_STAGE(PG8_SB(0, 1), b2 + hstep, voffB);
            PG8_WAIT_V(6); PG8_BAR; PG8_MMA(1, 1, At, B1); PG8_BAR;
            PG8_LDB(B0, 1, 0); PG8_SCHED; PG8_LDA(At, 1, 0); PG8_STAGE(PG8_SA(0, 1), a2 + hstep, voffA);
            PG8_WAIT_L(8); PG8_BAR; PG8_WAIT_L(0); PG8_MMA(0, 0, At, B0); PG8_BAR; PG8_SCHED;
            PG8_LDB(B1, 1, 1); PG8_STAGE(PG8_SB(1, 0), b3, voffB);
            PG8_BAR; PG8_WAIT_L(0); PG8_MMA(0, 1, At, B1); PG8_BAR;
            PG8_LDA(At, 1, 1); PG8_STAGE(PG8_SA(1, 0), a3, voffA);
            PG8_BAR; PG8_WAIT_L(0); PG8_MMA(1, 0, At, B0); PG8_BAR; PG8_SCHED;
            PG8_STAGE(PG8_SB(1, 1), b3 + hstep, voffB);
            PG8_WAIT_V(6); PG8_BAR; PG8_MMA(1, 1, At, B1); PG8_BAR;
            }
        }
        if constexpr (F8) asm volatile("s_nop 15\n\ts_nop 15" ::: "memory");
        if constexpr (ALIGN_EPI) { if (wr == 0) PG8_BAR; }
        if constexpr (!Epi::AFTER_DRAIN) { E(acc, cur, wr, wc, fr, fq); S.done(cur); }
        if (!has_next) break;
#pragma unroll
        for (int a = 0; a < 2; ++a)
#pragma unroll
            for (int b = 0; b < 2; ++b)
#pragma unroll
                for (int m = 0; m < 4; ++m)
#pragma unroll
                    for (int n = 0; n < 2; ++n) acc[a][b][m][n] = (f32x4){0.f, 0.f, 0.f, 0.f};
        cur = nxt; cA = nA; cB = nB; ++ui;
        if constexpr (ALIGN_EPI) { if (wr == 1) PG8_BAR; }
    }
    PG8_WAIT_V(0);
    if constexpr (!ALIGN_EPI) { if (wr == 0) PG8_BAR; }
    PG8_BAR;
    if constexpr (Epi::AFTER_DRAIN) { E.fused(acc, cur, wr, wc, fr, fq, lds, wid, lane); S.done(cur); }
#undef PG8_SA
#undef PG8_SB
#undef PG8_STAGE
#undef PG8_LDA
#undef PG8_LDB
#undef PG8_MMA
#undef PG8_WAIT_V
#undef PG8_WAIT_L
#undef PG8_BAR
#undef PG8_SCHED
}
}

namespace cg = cooperative_groups;
#define LAS __attribute__((address_space(3)))
typedef unsigned short bf16;
typedef unsigned v4u __attribute__((ext_vector_type(4)));
typedef unsigned v2u __attribute__((ext_vector_type(2)));
typedef float f32x4 __attribute__((ext_vector_type(4)));
typedef short bf16x8 __attribute__((ext_vector_type(8)));
typedef short s16x4 __attribute__((ext_vector_type(4)));

constexpr int NWAVES = 8;
constexpr int T = 12288, TP = 4096, D = 1024, FF = 2816, NGU = 5632, NQKV = 1536, NMOD = 9216;
constexpr float ALPHA = 1.4142135623730951f;
constexpr float LN_EPS = 1e-5f;
constexpr float LOG2E = 1.4426950408889634f;
constexpr int LDS_BYTES = 147456;
constexpr int N_PHASES = 22;

constexpr size_t MiB = 1u << 20;
constexpr size_t WS_CTL = 0, CTL_ZERO_BYTES = 65536, WS_BAR = 16384;
constexpr int MISC_OFF = 131072 + 320;
constexpr size_t WS_MODV = 1 * MiB;
constexpr size_t WS_ROPE = 1 * MiB + 512 * 1024;
constexpr size_t WS_KC = 2 * MiB;
constexpr size_t WS_VCT = 2 * MiB + 512 * 1024;
constexpr size_t WS_PART = 4 * MiB;
constexpr size_t WS_WQKV = 8 * MiB, WS_WO = 11 * MiB, WS_WP = 13 * MiB;
constexpr size_t WS_WGU = 16 * MiB;
constexpr size_t WS_WD = 60 * MiB;
constexpr size_t WS_H = 82 * MiB;
constexpr size_t WS_A = 106 * MiB;
constexpr size_t WS_Q = 106 * MiB, WS_O = 130 * MiB;
constexpr size_t WS_KB = 172 * MiB;
constexpr size_t WS_VT = 178 * MiB;
constexpr size_t WS_END = 184 * MiB;

struct Args {
    const float* in[18];
    float* out;
    unsigned char* ws;
    int ph_lo, ph_hi;
};

#define LDS_WAIT() asm volatile("s_waitcnt lgkmcnt(0)" ::: "memory")
__device__ __forceinline__ unsigned pkbf(float lo, float hi) { return pg8::cvt_pk_bf16(lo, hi); }
__device__ __forceinline__ unsigned pk8(float a, float b, float c, float d) { int w = __builtin_amdgcn_cvt_pk_fp8_f32(a, b, 0, false); w = __builtin_amdgcn_cvt_pk_fp8_f32(c, d, w, true); return (unsigned)w; }
constexpr float WGU_SCALE = 64.f, WD_SCALE = 128.f;
__device__ __forceinline__ float wave_sum(float v) {
#pragma unroll
    for (int o = 1; o < 64; o <<= 1) v += __shfl_xor(v, o);
    return v;
}
__device__ __forceinline__ float silu_f(float x) { return x / (1.f + __expf(-x)); }

struct EpiSwiglu {
    static constexpr bool PERM = false, AFTER_DRAIN = false;
    unsigned char* A;
    __device__ __forceinline__ void operator()(const f32x4 (&acc)[2][2][4][2], const pg8::Unit& u, int wr, int wc, int fr, int fq) const {
        const int col = u.pn * 128 + wc * 32 + 8 * fq;
#pragma unroll
        for (int ai = 0; ai < 2; ++ai)
#pragma unroll
            for (int m = 0; m < 4; ++m) {
                const int row = u.pm * 256 + ai * 128 + wr * 64 + m * 16 + fr;
                float v[8];
#pragma unroll
                for (int n = 0; n < 2; ++n)
#pragma unroll
                    for (int e = 0; e < 4; ++e) { const float g = acc[ai][0][m][n][e] * (1.f / WGU_SCALE), up = acc[ai][1][m][n][e] * (1.f / WGU_SCALE); v[n * 4 + e] = g * __builtin_amdgcn_rcpf(1.f + __expf(-g)) * up; }
                v2u w; w.x = pk8(v[0], v[1], v[2], v[3]); w.y = pk8(v[4], v[5], v[6], v[7]);
                *(v2u*)(A + (size_t)row * FF + col) = w;
            }
    }
};
struct EpiResid {
    static constexpr bool PERM = false, AFTER_DRAIN = false;
    float* xy; const float* gate; const float* cscale; float mult;
    __device__ __forceinline__ void operator()(const f32x4 (&acc)[2][2][4][2], const pg8::Unit& u, int wr, int wc, int fr, int fq) const {
        const int cond = u.pm < 16 ? 0 : (u.pm < 32 ? 1 : 2);
        const float* g = gate + cond * NMOD;
#pragma unroll
        for (int bj = 0; bj < 2; ++bj)
#pragma unroll
            for (int n = 0; n < 2; ++n) {
                const int c = u.pn * 256 + bj * 128 + wc * 32 + n * 16 + 4 * fq;
                f32x4 gv = *(const f32x4*)(g + c) * mult;
                if (cscale) gv = gv * *(const f32x4*)(cscale + c);
#pragma unroll
                for (int ai = 0; ai < 2; ++ai)
#pragma unroll
                    for (int m = 0; m < 4; ++m) {
                        const int row = u.pm * 256 + ai * 128 + wr * 64 + m * 16 + fr;
                        float* p = xy + (size_t)row * D + c;
                        const f32x4 x = *(const f32x4*)p;
                        *(f32x4*)p = x * ALPHA + gv * acc[ai][bj][m][n];
                    }
            }
    }
};
struct EpiQKV {
    static constexpr bool PERM = false, AFTER_DRAIN = false;
    bf16* Q; bf16* Kb; bf16* Vt; float* sk; float* sv; const float* cosT; const float* sinT;
    __device__ __forceinline__ void operator()(const f32x4 (&acc)[2][2][4][2], const pg8::Unit& u, int wr, int wc, int fr, int fq) const {
        const int pn = u.pn;
#pragma unroll
        for (int ai = 0; ai < 2; ++ai)
#pragma unroll
            for (int m = 0; m < 4; ++m) {
                const int row = u.pm * 256 + ai * 128 + wr * 64 + m * 16 + fr;
                const bool latent = row >= TP;
                const int pos = (row - TP) & 4095;
                const int gpos = (wc & 1) ? (pos & 63) : (pos >> 6);
#pragma unroll
                for (int bj = 0; bj < 2; ++bj) {
                    f32x4 a0 = acc[ai][bj][m][0], a1 = acc[ai][bj][m][1];
                    const int cl = bj * 128 + wc * 32 + 4 * fq;
                    if (pn < 5 && latent) {
                        const f32x4 cs = *(const f32x4*)(cosT + gpos * 16 + 4 * fq), sn = *(const f32x4*)(sinT + gpos * 16 + 4 * fq);
                        const f32x4 r0 = a0 * cs - a1 * sn, r1 = a1 * cs + a0 * sn; a0 = r0; a1 = r1;
                    }
                    v2u w0, w1; w0.x = pkbf(a0[0], a0[1]); w0.y = pkbf(a0[2], a0[3]); w1.x = pkbf(a1[0], a1[1]); w1.y = pkbf(a1[2], a1[3]);
                    if (pn < 4) {
                        bf16* q = Q + (size_t)row * D + pn * 256 + cl;
                        *(v2u*)q = w0; *(v2u*)(q + 16) = w1;
                    } else if (pn == 4) {
                        bf16* k = Kb + (size_t)row * 256 + cl;
                        *(v2u*)k = w0; *(v2u*)(k + 16) = w1;
                        if (!latent) { float* s = sk + (size_t)row * 256 + cl; *(f32x4*)s = a0; *(f32x4*)(s + 16) = a1; }
                    } else {
                        bf16* v = Vt + (size_t)cl * T + row;
                        v[0] = (bf16)(w0.x & 0xffffu); v[(size_t)T] = (bf16)(w0.x >> 16); v[(size_t)2 * T] = (bf16)(w0.y & 0xffffu); v[(size_t)3 * T] = (bf16)(w0.y >> 16);
                        v += (size_t)16 * T;
                        v[0] = (bf16)(w1.x & 0xffffu); v[(size_t)T] = (bf16)(w1.x >> 16); v[(size_t)2 * T] = (bf16)(w1.y & 0xffffu); v[(size_t)3 * T] = (bf16)(w1.y >> 16);
                        if (!latent) { float* s = sv + (size_t)row * 256 + cl; *(f32x4*)s = a0; *(f32x4*)(s + 16) = a1; }
                    }
                }
            }
    }
};

__device__ __forceinline__ void tr_item(const float* W, int ldw, int k0, int n0, bf16* WT, int ldwt, int orow0, int ocol0, LAS float* scr, int lane) {
#pragma unroll 8
    for (int i = 0; i < 32; ++i) { const int kk = 2 * i + (lane >> 5); scr[kk * 33 + (lane & 31)] = W[(size_t)(k0 + kk) * ldw + n0 + (lane & 31)]; }
    LDS_WAIT(); asm volatile("" ::: "memory");
    const int c = lane & 7;
#pragma unroll
    for (int j = 0; j < 4; ++j) { const int n = (lane >> 3) + 8 * j; const LAS float* s = scr + (8 * c) * 33 + n;
        v4u o; o.x = pkbf(s[0 * 33], s[1 * 33]); o.y = pkbf(s[2 * 33], s[3 * 33]); o.z = pkbf(s[4 * 33], s[5 * 33]); o.w = pkbf(s[6 * 33], s[7 * 33]);
        *(v4u*)(WT + (size_t)(orow0 + n) * ldwt + ocol0 + k0 + 8 * c) = o; }
    LDS_WAIT(); asm volatile("" ::: "memory");
}
__device__ __forceinline__ void tr_item8(const float* W, int ldw, int k0, int n0, unsigned char* WT, int ldwt, int orow0, float scale, bool perm, LAS float* scr, int lane) {
#pragma unroll 8
    for (int i = 0; i < 32; ++i) { const int kk = 2 * i + (lane >> 5); scr[kk * 33 + (lane & 31)] = W[(size_t)(k0 + kk) * ldw + n0 + (lane & 31)] * scale; }
    LDS_WAIT(); asm volatile("" ::: "memory");
#pragma unroll
    for (int j = 0; j < 2; ++j) { const int q = lane + 64 * j, n = q >> 2, c = q & 3; const LAS float* p = scr + (16 * c) * 33 + n;
        v4u o; o.x = pk8(p[0 * 33], p[1 * 33], p[2 * 33], p[3 * 33]); o.y = pk8(p[4 * 33], p[5 * 33], p[6 * 33], p[7 * 33]);
        o.z = pk8(p[8 * 33], p[9 * 33], p[10 * 33], p[11 * 33]); o.w = pk8(p[12 * 33], p[13 * 33], p[14 * 33], p[15 * 33]);
        const int nr = perm ? (16 * ((n >> 2) & 1) + 4 * (n >> 3) + (n & 3)) : n;
        *(v4u*)(WT + (size_t)(orow0 + nr) * ldwt + k0 + 16 * c) = o; }
    LDS_WAIT(); asm volatile("" ::: "memory");
}
__device__ __forceinline__ void modv_item(const float* w_mod, const float* c, const float* c_ctx, float* part, int r, int lane) {
    const int l = r / 576, q = r % 576, nb = q / 16, kc = q % 16;
    const int k0 = kc * 64, n = nb * 256 + 4 * lane;
    const float s0 = silu_f(c_ctx[k0 + lane]), s1 = silu_f(c[k0 + lane]), s2 = silu_f(c[1024 + k0 + lane]);
    const float* W = w_mod + ((size_t)l * 1024 + k0) * NMOD + n;
    f32x4 a0 = {0.f, 0.f, 0.f, 0.f}, a1 = a0, a2 = a0;
#pragma unroll 16
    for (int kk = 0; kk < 64; ++kk) {
        const f32x4 w = __builtin_nontemporal_load((const f32x4*)(W + (size_t)kk * NMOD));
        const float t0 = __shfl(s0, kk), t1 = __shfl(s1, kk), t2 = __shfl(s2, kk);
        a0 += w * t0; a1 += w * t1; a2 += w * t2;
    }
    float* P = part + ((size_t)(kc * 2 + l) * 3) * NMOD + n;
    *(f32x4*)P = a0; *(f32x4*)(P + NMOD) = a1; *(f32x4*)(P + 2 * NMOD) = a2;
}

constexpr int I_MODV = 2 * 36 * 16, I_GU = 4 * 2 * 1408, I_DN = 4 * 1408, I_QKV = 16 * 48, I_WO = 16 * 32, I_POOL = 128, I_PZ = 1024, I_CV = 64, I_CK = 64, I_ROPE = 1;
constexpr int NITEMS = I_MODV + I_GU + I_DN + I_QKV + I_WO + I_POOL + I_PZ + I_CV + I_CK + I_ROPE;

__device__ __forceinline__ void p0a_phase(const Args& a, LAS unsigned char* ldsp, int gw, int NGW, int wave, int lane) {
    LAS float* scr = (LAS float*)(ldsp + wave * 16384);
    unsigned char* ws = a.ws;
    for (int it = gw; it < NITEMS; it += NGW) {
        int r = it;
        if (r < I_MODV) { modv_item(a.in[6], a.in[4], a.in[5], (float*)(ws + WS_PART), r, lane); continue; } r -= I_MODV;
        if (r < I_GU) { const int lj = r / 2816, rr = r % 2816, up = rr / 1408, q = rr % 1408, kb = q / 88, nb = q % 88, n0 = 32 * nb;
            tr_item8((up ? a.in[11] : a.in[10]) + (size_t)lj * D * FF, FF, 64 * kb, n0, ws + WS_WGU + (size_t)lj * NGU * D, D, 256 * (n0 / 128) + (n0 % 128) + (up ? 128 : 0), WGU_SCALE, true, scr, lane); continue; } r -= I_GU;
        if (r < I_DN) { const int lj = r / 1408, q = r % 1408, kb = q / 32, nb = q % 32;
            tr_item8(a.in[12] + (size_t)lj * FF * D, D, 64 * kb, 32 * nb, ws + WS_WD + (size_t)lj * D * FF, FF, 32 * nb, WD_SCALE, false, scr, lane); continue; } r -= I_DN;
        if (r < I_QKV) { const int kb = r / 48, nb = r % 48; tr_item(a.in[13], NQKV, 64 * kb, 32 * nb, (bf16*)(ws + WS_WQKV), D, 32 * nb, 0, scr, lane); continue; } r -= I_QKV;
        if (r < I_WO) { const int kb = r / 32, nb = r % 32; tr_item(a.in[14], D, 64 * kb, 32 * nb, (bf16*)(ws + WS_WO), D, 32 * nb, 0, scr, lane); continue; } r -= I_WO;
        if (r < I_POOL) { const int g = r / 32, rr = r % 32, kb = rr / 8, nb = rr % 8;
            tr_item(a.in[16] + (size_t)g * 65536, 256, 64 * kb, 32 * nb, (bf16*)(ws + WS_WP), D, 256 * g + 32 * nb, 256 * g, scr, lane); continue; } r -= I_POOL;
        if (r < I_PZ) { bf16* row = (bf16*)(ws + WS_WP) + (size_t)r * D; const int g = r >> 8;
#pragma unroll
            for (int i = 0; i < 2; ++i) { const int ch = lane + 64 * i; if (((8 * ch) >> 8) != g) *(v4u*)(row + 8 * ch) = (v4u){0u, 0u, 0u, 0u}; }
            continue; } r -= I_PZ;
        if (r < I_CV) { const int b = r / 32, rr = r % 32, kb = rr / 8, nb = rr % 8;
            tr_item(a.in[3] + (size_t)b * 65536, 256, 64 * kb, 32 * nb, (bf16*)(ws + WS_VCT) + (size_t)b * 65536, 256, 32 * nb, 0, scr, lane); continue; } r -= I_CV;
        if (r < I_CK) { const float* src = a.in[2] + (size_t)r * 2048; bf16* dst = (bf16*)(ws + WS_KC) + (size_t)r * 2048;
#pragma unroll
            for (int i = 0; i < 4; ++i) { const int idx = i * 512 + lane * 8; const f32x4 x = *(const f32x4*)(src + idx), y = *(const f32x4*)(src + idx + 4);
                v4u o; o.x = pkbf(x[0], x[1]); o.y = pkbf(x[2], x[3]); o.z = pkbf(y[0], y[1]); o.w = pkbf(y[2], y[3]); *(v4u*)(dst + idx) = o; }
            continue; } r -= I_CK;
        { float* cosT = (float*)(ws + WS_ROPE); float* sinT = cosT + 1024;
#pragma unroll 1
            for (int f = 0; f < 16; ++f) { const float inv = exp2f(-(float)f * (13.287712379549449f / 16.f)); const float ang = (float)lane * inv;
                cosT[lane * 16 + f] = cosf(ang); sinT[lane * 16 + f] = sinf(ang); } }
    }
}
__device__ __forceinline__ void p0b_phase(const Args& a, int gtid, int NT) {
    const float* part = (const float*)(a.ws + WS_PART); float* modv = (float*)(a.ws + WS_MODV); const float* b_mod = a.in[7];
    for (int i = gtid; i < 2 * 3 * (NMOD / 4); i += NT) {
        const int l = i / 6912, rem = i % 6912, cond = rem / 2304, n = 4 * (rem % 2304);
        f32x4 s = *(const f32x4*)(b_mod + l * NMOD + n);
#pragma unroll
        for (int kc = 0; kc < 16; ++kc) s += *(const f32x4*)(part + ((size_t)(kc * 2 + l) * 3 + cond) * NMOD + n);
        *(f32x4*)(modv + (size_t)(l * 3 + cond) * NMOD + n) = s;
    }
}

__device__ __forceinline__ void ln_phase(int mode, int f8, const float* xin_p, const float* xin_s, float* xy, bf16* H, const float* g, const float* b,
                                         const float* modl, int ishift, int iscale, int gw, int NGW, int lane) {
    for (int r = gw; r < T; r += NGW) {
        const int cond = r < TP ? 0 : (r < 2 * TP ? 1 : 2);
        const float* src = (mode == 0) ? (r < TP ? xin_p + (size_t)r * D : xin_s + (size_t)(r - TP) * D) : xy + (size_t)r * D;
        f32x4 v[4];
#pragma unroll
        for (int j = 0; j < 4; ++j) v[j] = *(const f32x4*)(src + 256 * j + 4 * lane);
        if (mode != 0) {
            float s = 0.f;
#pragma unroll
            for (int j = 0; j < 4; ++j) s += (v[j][0] + v[j][1]) + (v[j][2] + v[j][3]);
            const float mean = wave_sum(s) * (1.f / D); float s2 = 0.f;
#pragma unroll
            for (int j = 0; j < 4; ++j) { v[j] = v[j] - mean; s2 += (v[j][0] * v[j][0] + v[j][1] * v[j][1]) + (v[j][2] * v[j][2] + v[j][3] * v[j][3]); }
            const float rstd = 1.f / sqrtf(wave_sum(s2) * (1.f / D) + LN_EPS);
#pragma unroll
            for (int j = 0; j < 4; ++j) v[j] = v[j] * rstd * *(const f32x4*)(g + 256 * j + 4 * lane) + *(const f32x4*)(b + 256 * j + 4 * lane);
        }
#pragma unroll
        for (int j = 0; j < 4; ++j) *(f32x4*)(xy + (size_t)r * D + 256 * j + 4 * lane) = v[j];
        if (mode != 2) {
            const float* sh = modl + cond * NMOD + ishift * D; const float* sc = modl + cond * NMOD + iscale * D;
#pragma unroll
            for (int j = 0; j < 4; ++j) { const f32x4 h = v[j] * (*(const f32x4*)(sc + 256 * j + 4 * lane) + 1.f) + *(const f32x4*)(sh + 256 * j + 4 * lane);
                if (f8) { *(unsigned*)((unsigned char*)H + (size_t)r * D + 256 * j + 4 * lane) = pk8(h[0], h[1], h[2], h[3]); }
                else { v2u w; w.x = pkbf(h[0], h[1]); w.y = pkbf(h[2], h[3]); *(v2u*)(H + (size_t)r * D + 256 * j + 4 * lane) = w; } }
        }
    }
}
__device__ __forceinline__ void pool_phase(const float* xy, bf16* P, const float* modl, int iscale, int gw, int NGW, int lane) {
    for (int r = gw; r < T; r += NGW) {
        const int cond = r < TP ? 0 : (r < 2 * TP ? 1 : 2);
        const int s0 = r < TP ? (r & ~255) : (TP + ((r - TP) & ~4095)), L = r < TP ? 256 : 4096, pos = r - s0;
        const float* sc = modl + cond * NMOD + iscale * D;
#pragma unroll
        for (int j = 0; j < 4; ++j) {
            const int hw = 1 << j, lo = max(pos - hw, 0), hi = min(pos + hw, L);
            f32x4 sum = {0.f, 0.f, 0.f, 0.f};
            for (int jj = lo; jj < hi; ++jj) sum += *(const f32x4*)(xy + (size_t)(s0 + jj) * D + 256 * j + 4 * lane);
            const f32x4 ctr = *(const f32x4*)(xy + (size_t)r * D + 256 * j + 4 * lane);
            const float cnt = (float)(hi - lo);
            f32x4 pl; pl[0] = sum[0] / cnt - ctr[0]; pl[1] = sum[1] / cnt - ctr[1]; pl[2] = sum[2] / cnt - ctr[2]; pl[3] = sum[3] / cnt - ctr[3];
            pl = pl * (*(const f32x4*)(sc + 256 * j + 4 * lane) + 1.f);
            v2u w; w.x = pkbf(pl[0], pl[1]); w.y = pkbf(pl[2], pl[3]); *(v2u*)(P + (size_t)r * D + 256 * j + 4 * lane) = w;
        }
    }
}

struct AttnState { float m[4], l[4]; f32x4 o[4][4]; };
template <bool MASK>
__device__ __forceinline__ void attn_tiles(AttnState& st, const bf16x8 (&qf)[4][2], const bf16* Kp, const bf16* Vp, int ldv, int kbeg, int kend, int qpos, int fr, int fq) {
    constexpr float SC = 0.125f * LOG2E;
    for (int ks = kbeg; ks < kend; ks += 32) {
        bf16x8 kf[2][2]; bf16x8 vf[4];
#pragma unroll
        for (int s = 0; s < 2; ++s)
#pragma unroll
            for (int dc = 0; dc < 2; ++dc) kf[s][dc] = *(const bf16x8*)(Kp + (size_t)(ks + 16 * s + fr) * 256 + dc * 32 + fq * 8);
#pragma unroll
        for (int dd = 0; dd < 4; ++dd) { const bf16* vp = Vp + (size_t)(16 * dd + fr) * ldv + ks + 4 * fq; const s16x4 lo = *(const s16x4*)vp, hi = *(const s16x4*)(vp + 16);
            vf[dd] = (bf16x8){lo[0], lo[1], lo[2], lo[3], hi[0], hi[1], hi[2], hi[3]}; }
#pragma unroll
        for (int hh = 0; hh < 4; ++hh) {
            f32x4 s0 = {0.f, 0.f, 0.f, 0.f}, s1 = s0;
            s0 = __builtin_amdgcn_mfma_f32_16x16x32_bf16(kf[0][0], qf[hh][0], s0, 0, 0, 0); s0 = __builtin_amdgcn_mfma_f32_16x16x32_bf16(kf[0][1], qf[hh][1], s0, 0, 0, 0);
            s1 = __builtin_amdgcn_mfma_f32_16x16x32_bf16(kf[1][0], qf[hh][0], s1, 0, 0, 0); s1 = __builtin_amdgcn_mfma_f32_16x16x32_bf16(kf[1][1], qf[hh][1], s1, 0, 0, 0);
            s0 = s0 * SC; s1 = s1 * SC;
            if (MASK) {
#pragma unroll
                for (int e = 0; e < 4; ++e) { const int k0 = ks + 4 * fq + e, d0 = qpos - k0, d1 = d0 - 16;
                    if (d0 > 128 || d0 < -128) s0[e] = -1e30f; if (d1 > 128 || d1 < -128) s1[e] = -1e30f; }
            }
            float rm = fmaxf(fmaxf(fmaxf(s0[0], s0[1]), fmaxf(s0[2], s0[3])), fmaxf(fmaxf(s1[0], s1[1]), fmaxf(s1[2], s1[3])));
            rm = fmaxf(rm, __shfl_xor(rm, 16)); rm = fmaxf(rm, __shfl_xor(rm, 32));
            const float mn = fmaxf(st.m[hh], rm), f = __builtin_amdgcn_exp2f(st.m[hh] - mn); st.m[hh] = mn;
            float p[8];
#pragma unroll
            for (int e = 0; e < 4; ++e) { p[e] = __builtin_amdgcn_exp2f(s0[e] - mn); p[4 + e] = __builtin_amdgcn_exp2f(s1[e] - mn); }
            st.l[hh] = st.l[hh] * f + ((p[0] + p[1]) + (p[2] + p[3])) + ((p[4] + p[5]) + (p[6] + p[7]));
            v4u pw; pw.x = pkbf(p[0], p[1]); pw.y = pkbf(p[2], p[3]); pw.z = pkbf(p[4], p[5]); pw.w = pkbf(p[6], p[7]);
            const bf16x8 pf = __builtin_bit_cast(bf16x8, pw);
#pragma unroll
            for (int dd = 0; dd < 4; ++dd) { st.o[hh][dd] = st.o[hh][dd] * f; st.o[hh][dd] = __builtin_amdgcn_mfma_f32_16x16x32_bf16(vf[dd], pf, st.o[hh][dd], 0, 0, 0); }
        }
    }
}
__device__ __forceinline__ void attn_phase(const bf16* Q, const bf16* Kb, const bf16* Vt, const bf16* Kc, const bf16* Vct, bf16* O, const float* sink, int gw, int NGW, int lane) {
    const int fr = lane & 15, fq = lane >> 4;
    for (int item = gw; item < 3072; item += NGW) {
        int seqbase, kvh, t0, b; const bool latent = item < 2048;
        if (latent) { b = item >> 10; kvh = (item >> 8) & 3; t0 = (item & 255) * 16; seqbase = TP + b * 4096; }
        else { const int it = item - 2048; b = it >> 6; kvh = (it >> 4) & 3; t0 = (it & 15) * 16; seqbase = b * 256; }
        bf16x8 qf[4][2];
#pragma unroll
        for (int hh = 0; hh < 4; ++hh)
#pragma unroll
            for (int dc = 0; dc < 2; ++dc) qf[hh][dc] = *(const bf16x8*)(Q + (size_t)(seqbase + t0 + fr) * D + (kvh * 4 + hh) * 64 + dc * 32 + fq * 8);
        AttnState st;
#pragma unroll
        for (int hh = 0; hh < 4; ++hh) { st.m[hh] = sink[kvh * 4 + hh] * LOG2E; st.l[hh] = (fq == 0) ? 1.f : 0.f;
#pragma unroll
            for (int dd = 0; dd < 4; ++dd) st.o[hh][dd] = (f32x4){0.f, 0.f, 0.f, 0.f}; }
        const bf16* Kp = Kb + (size_t)seqbase * 256 + kvh * 64; const bf16* Vp = Vt + (size_t)(kvh * 64) * T + seqbase;
        if (latent) {
            const int kb = max(0, t0 - 128) & ~31, ke = min(4096, t0 + 144);
            attn_tiles<true>(st, qf, Kp, Vp, T, kb, ke, t0 + fr, fr, fq);
            attn_tiles<false>(st, qf, Kc + (size_t)b * 65536 + kvh * 64, Vct + (size_t)b * 65536 + (size_t)(kvh * 64) * 256, 256, 0, 256, 0, fr, fq);
        } else {
            attn_tiles<false>(st, qf, Kp, Vp, T, 0, 256, 0, fr, fq);
        }
#pragma unroll
        for (int hh = 0; hh < 4; ++hh) {
            float l = st.l[hh]; l += __shfl_xor(l, 16); l += __shfl_xor(l, 32);
            const float inv = 1.f / l;
            bf16* op = O + (size_t)(seqbase + t0 + fr) * D + (kvh * 4 + hh) * 64 + 4 * fq;
#pragma unroll
            for (int dd = 0; dd < 4; ++dd) { const f32x4 o = st.o[hh][dd] * inv; v2u w; w.x = pkbf(o[0], o[1]); w.y = pkbf(o[2], o[3]); *(v2u*)(op + 16 * dd) = w; }
        }
    }
}

#define XB_TMO      128
#define XB_XCNT(j)  (256  + 64 * (j))
#define XB_XSUB(j)  (1280 + 64 * (j))
#define XB_XGEN(j)  (2304 + 64 * (j))
#define XB_TOP      3328
#define XB_TOPGEN   3392
#define XCD_BAR_WORDS 3456
#define XB_SPIN_CAP (1u << 18)

__device__ __forceinline__ unsigned xb_ld(unsigned* p)              { return __hip_atomic_load(p, __ATOMIC_RELAXED, __HIP_MEMORY_SCOPE_AGENT); }
__device__ __forceinline__ unsigned xb_add(unsigned* p, unsigned v) { return __hip_atomic_fetch_add(p, v, __ATOMIC_RELAXED, __HIP_MEMORY_SCOPE_AGENT); }
__device__ __forceinline__ unsigned xb_xcc_id() { return (unsigned)__builtin_amdgcn_s_getreg((3 << 11) | 20) & 0xFu; }
#define XB_SPIN(cond, bar) do { unsigned _sp = 0; while (cond) { __builtin_amdgcn_s_sleep(1); \
    if ((++_sp & 255u) == 0u) { if (xb_ld(&(bar)[XB_TMO])) break; if (_sp > XB_SPIN_CAP) { atomicAdd(&(bar)[XB_TMO], 1u); break; } } } } while (0)

struct XcdBarrier {
    unsigned* bar; unsigned x;
    volatile LAS unsigned* st;
};

__device__ __forceinline__ XcdBarrier xcd_barrier_post(unsigned* bar, volatile LAS unsigned* st) {
    XcdBarrier b; b.bar = bar; b.x = xb_xcc_id(); b.st = st;
    if (threadIdx.x == 0) (void)xb_add(&bar[XB_XCNT(b.x)], 1u);
    return b;
}
__device__ __forceinline__ void xcd_barrier_complete(unsigned* bar, unsigned x, unsigned& nloc, unsigned& nx) {
    const unsigned G = gridDim.x * gridDim.y * gridDim.z;
    unsigned sum, cnt, mine, sp = 0u;
    for (;;) {
        sum = 0u; cnt = 0u; mine = 0u;
#pragma unroll
        for (unsigned j = 0; j < 16; ++j) { const unsigned c = xb_ld(&bar[XB_XCNT(j)]); sum += c; cnt += (c > 0u) ? 1u : 0u; mine = (j == x) ? c : mine; }
        if (sum == G) break;
        __builtin_amdgcn_s_sleep(1);
        if ((++sp & 255u) == 0u) { if (xb_ld(&bar[XB_TMO])) break; if (sp > XB_SPIN_CAP) { atomicAdd(&bar[XB_TMO], 1u); break; } }
    }
    nloc = mine > 0u ? mine : 1u; nx = cnt > 0u ? cnt : 1u;
}

__device__ __forceinline__ void xcd_barrier(const XcdBarrier& b) {
    asm volatile("s_waitcnt vmcnt(0)" ::: "memory");
    __syncthreads();
    if (threadIdx.x == 0) {
        unsigned* bar = b.bar;
        __builtin_amdgcn_s_waitcnt(0);
        unsigned nloc = b.st[0], nx = b.st[1];
        if (nloc == 0u) { xcd_barrier_complete(bar, b.x, nloc, nx); b.st[0] = nloc; b.st[1] = nx; }
        const unsigned old = xb_add(&bar[XB_XSUB(b.x)], 1u);
        const unsigned gen = old / nloc;
        if (old + 1u == (gen + 1u) * nloc) {
            __builtin_amdgcn_fence(__ATOMIC_RELEASE, "agent");
            asm volatile("s_waitcnt vmcnt(0)" ::: "memory");
            const unsigned og = xb_add(&bar[XB_TOP], 1u);
            const unsigned tg = og / nx;
            if (og + 1u == (tg + 1u) * nx) xb_add(&bar[XB_TOPGEN], 1u);
            else XB_SPIN(xb_ld(&bar[XB_TOPGEN]) == tg, bar);
            __builtin_amdgcn_fence(__ATOMIC_ACQUIRE, "agent");
            xb_add(&bar[XB_XGEN(b.x)], 1u);
            asm volatile("s_waitcnt vmcnt(0)" ::: "memory");
        } else {
            XB_SPIN(xb_ld(&bar[XB_XGEN(b.x)]) == gen, bar);
            __builtin_amdgcn_fence(__ATOMIC_ACQUIRE, "agent");
            asm volatile("s_waitcnt vmcnt(0)" ::: "memory");
        }
    }
    __syncthreads();
}

enum { K_P0A = 0, K_P0B, K_LN, K_UP, K_RES, K_QKV, K_ATT, K_POOL };

__global__ void __launch_bounds__(NWAVES * 64, 2) mk_fwd(Args args) {
    extern __shared__ __attribute__((aligned(16))) unsigned char lds[];
    LAS unsigned char* ldsp = (LAS unsigned char*)lds;
    const int tid = threadIdx.x, lane = tid & 63, wave = __builtin_amdgcn_readfirstlane(tid >> 6);
    const int G = gridDim.x, gw = blockIdx.x * NWAVES + wave, NGW = G * NWAVES;
    unsigned char* ws = args.ws;
    float* xy = args.out;
    float* sk = args.out + (size_t)T * D; float* sv = sk + (size_t)TP * 256;
    float* modv = (float*)(ws + WS_MODV);
    bf16* H = (bf16*)(ws + WS_H); bf16* A = (bf16*)(ws + WS_A); bf16* Qb = (bf16*)(ws + WS_Q); bf16* Ob = (bf16*)(ws + WS_O);
    bf16* Kb = (bf16*)(ws + WS_KB); bf16* Vt = (bf16*)(ws + WS_VT);

    const int lo = args.ph_lo, hi = args.ph_hi;
    for (int u = tid; u < (LDS_BYTES - 131072) / 4; u += NWAVES * 64) ((LAS unsigned*)(ldsp + 131072))[u] = 0u;
    __syncthreads();
    XcdBarrier bar; bar.bar = (unsigned*)(ws + WS_BAR); bar.x = 0; bar.st = nullptr;
    if (hi - lo > 1) bar = xcd_barrier_post((unsigned*)(ws + WS_BAR), (volatile LAS unsigned*)(ldsp + MISC_OFF) + 8);
    if (lo > 1000) cg::this_grid().sync();
#define IN(k) (lo <= (k) && (k) < hi)
#define SEAM(k) do { if ((k) + 1 < hi) xcd_barrier(bar); } while (0)
#define MODL(l) (modv + (size_t)(l) * 3 * NMOD)
#define PH_LN(k, mode, f8, lnidx, l, mi) if (IN(k)) { ln_phase(mode, f8, args.in[0], args.in[1], xy, H, args.in[8] + (lnidx) * D, args.in[9] + (lnidx) * D, MODL(l), mi, (mi) + 1, gw, NGW, lane); SEAM(k); }
#define PH_UP(k, lj) if (IN(k)) { pg8::Gemm g{H, (const bf16*)(ws + WS_WGU + (size_t)(lj) * NGU * D), T, NGU, D / 2}; pg8::StaticOrder S; S.init(T, NGU, G, (int)blockIdx.x); \
        EpiSwiglu E{(unsigned char*)A}; pg8::gemm_phase<EpiSwiglu, pg8::StaticOrder, true, true, true>(ldsp, g, S, E); SEAM(k); }
#define PH_DOWN(k, lj, l, gi) if (IN(k)) { pg8::Gemm g{A, (const bf16*)(ws + WS_WD + (size_t)(lj) * D * FF), T, D, FF / 2}; pg8::StaticOrder S; S.init(T, D, G, (int)blockIdx.x); \
        EpiResid E{xy, MODL(l) + (gi) * D, nullptr, 0.5f / WD_SCALE}; pg8::gemm_phase<EpiResid, pg8::StaticOrder, true, true, true>(ldsp, g, S, E); SEAM(k); }
#define PH_RESD(k, Ap, Wp, l, gi, cs) if (IN(k)) { pg8::Gemm g{Ap, (const bf16*)(ws + (Wp)), T, D, D}; pg8::StaticOrder S; S.init(T, D, G, (int)blockIdx.x); \
        EpiResid E{xy, MODL(l) + (gi) * D, cs, 1.0f}; pg8::gemm_phase<EpiResid, pg8::StaticOrder, true, true>(ldsp, g, S, E); SEAM(k); }

#if PROBE == 4
    for (int i = 0; i < 20; ++i) xcd_barrier(bar);
#endif
    if (IN(0)) { p0a_phase(args, ldsp, gw, NGW, wave, lane); SEAM(0); }
#if PROBE == 1
    if (IN(0)) { p0a_phase(args, ldsp, gw, NGW, wave, lane); SEAM(0); }
#endif
    if (IN(1)) { p0b_phase(args, blockIdx.x * (NWAVES * 64) + tid, G * NWAVES * 64); SEAM(1); }
    PH_LN(2, 0, 1, 0, 0, 0)
    PH_UP(3, 0)
#if PROBE == 3
    PH_UP(3, 0)
#endif
    PH_DOWN(4, 0, 0, 2)
    PH_LN(5, 1, 0, 0, 0, 3)
    if (IN(6)) { pg8::Gemm g{H, (const bf16*)(ws + WS_WQKV), T, NQKV, D}; pg8::StaticOrder S; S.init(T, NQKV, G, (int)blockIdx.x);
        EpiQKV E{Qb, Kb, Vt, sk, sv, (const float*)(ws + WS_ROPE), (const float*)(ws + WS_ROPE) + 1024};
        pg8::gemm_phase<EpiQKV, pg8::StaticOrder, true, true>(ldsp, g, S, E); SEAM(6); }
    if (IN(7)) { attn_phase(Qb, Kb, Vt, (const bf16*)(ws + WS_KC), (const bf16*)(ws + WS_VCT), Ob, args.in[15], gw, NGW, lane); SEAM(7); }
#if PROBE == 2
    if (IN(7)) { attn_phase(Qb, Kb, Vt, (const bf16*)(ws + WS_KC), (const bf16*)(ws + WS_VCT), Ob, args.in[15], gw, NGW, lane); SEAM(7); }
    if (IN(7)) { attn_phase(Qb, Kb, Vt, (const bf16*)(ws + WS_KC), (const bf16*)(ws + WS_VCT), Ob, args.in[15], gw, NGW, lane); SEAM(7); }
#endif
    PH_RESD(8, Ob, WS_WO, 0, 5, nullptr)
    PH_LN(9, 1, 1, 1, 0, 6)
    PH_UP(10, 1)
    PH_DOWN(11, 1, 0, 8)
    PH_LN(12, 1, 1, 2, 1, 0)
    PH_UP(13, 2)
    PH_DOWN(14, 2, 1, 2)
    PH_LN(15, 2, 0, 3, 1, 0)
    if (IN(16)) { pool_phase(xy, H, MODL(1), 4, gw, NGW, lane); SEAM(16); }
#if PROBE == 5
    if (IN(16)) { pool_phase(xy, H, MODL(1), 4, gw, NGW, lane); SEAM(16); }
    if (IN(16)) { pool_phase(xy, H, MODL(1), 4, gw, NGW, lane); SEAM(16); }
#endif
    PH_RESD(17, H, WS_WP, 1, 5, args.in[17])
    PH_LN(18, 1, 1, 4, 1, 6)
    PH_UP(19, 3)
    PH_DOWN(20, 3, 1, 8)
    PH_LN(21, 2, 0, 5, 1, 0)
#undef IN
#undef SEAM
}

extern "C" void kernel_launch(void* const* d_in, const int* in_sizes, int n_in, void* d_out, int out_size, void* d_ws, size_t ws_size, hipStream_t stream) {
    static int grid = 0;
    if (grid == 0) {
        if (n_in != 18 || ws_size < WS_END) { fprintf(stderr, "kernel_launch: unexpected inputs (n_in %d, ws %zu)\n", n_in, ws_size); grid = -1; return; }
        int dev = 0, cus = 0, per_cu = 0;
        hipGetDevice(&dev); hipDeviceGetAttribute(&cus, hipDeviceAttributeMultiprocessorCount, dev);
        if (hipFuncSetAttribute((const void*)mk_fwd, hipFuncAttributeMaxDynamicSharedMemorySize, LDS_BYTES) != hipSuccess) { fprintf(stderr, "kernel_launch: hipFuncSetAttribute failed\n"); grid = -1; return; }
        if (hipOccupancyMaxActiveBlocksPerMultiprocessor(&per_cu, (const void*)mk_fwd, NWAVES * 64, LDS_BYTES) != hipSuccess || per_cu < 1) { fprintf(stderr, "kernel_launch: occupancy query says %d\n", per_cu); per_cu = 1; }
        (void)hipGetLastError();
        grid = cus * 1;
        if (grid <= 0) grid = 256;
    }
    if (grid < 0) return;
    if (hipMemsetAsync((char*)d_ws + WS_CTL, 0, CTL_ZERO_BYTES, stream) != hipSuccess) { fprintf(stderr, "kernel_launch: memset failed\n"); return; }
    Args a{};
    for (int i = 0; i < 18; ++i) a.in[i] = (const float*)d_in[i];
    a.out = (float*)d_out; a.ws = (unsigned char*)d_ws;
#if MK_PER_PHASE
    for (int ph = 0; ph < N_PHASES; ++ph) { a.ph_lo = ph; a.ph_hi = ph + 1; hipLaunchKernelGGL(mk_fwd, dim3(grid), dim3(NWAVES * 64), LDS_BYTES, stream, a); }
#else
    a.ph_lo = 0; a.ph_hi = N_PHASES;
    void* kargs[] = {&a};
    hipError_t e = hipLaunchCooperativeKernel((const void*)mk_fwd, dim3(grid), dim3(NWAVES * 64), kargs, LDS_BYTES, stream);
    if (e != hipSuccess) fprintf(stderr, "kernel_launch: cooperative launch failed: %s (grid %d)\n", hipGetErrorString(e), grid);
#endif
}
```
